# Optimizing an MI355X kernel written in HIP

```python
import jax
import jax.numpy as jnp
from jax import lax
import numpy as np

D_MODEL = 1024
BATCH = 4
SEQ = 4096
DEPTH = 1
DEC_BATCH = 32
DEC_SEQ = 16
PAST_LEN = 2048

CHUNK = 64
N_PAST_CHUNKS = 8
A_REACH = N_PAST_CHUNKS * CHUNK
BAND = A_REACH + CHUNK
H_A = 8
DH_A = 64
H_B = 8
DH_B = 64
H_M = 4
DH_M = 128
N_MEM = 256
REL_CLIP = 128
N_REL = 2 * REL_CLIP + 1
D_FF = 4 * D_MODEL
Q_BLOCK = 128
EPS = 1e-6
W_A = H_A * DH_A
W_B = H_B * DH_B
W_M = H_M * DH_M
N_BRANCH = 3
IN_SIZES = (W_A, W_A, W_A, W_B, W_B, W_B, H_B, W_M, N_BRANCH * D_MODEL)
IN_SPLITS = tuple(int(s) for s in np.cumsum(IN_SIZES)[:-1])
D_IN = int(sum(IN_SIZES))

kernel_name = 'chunk_streaming_hybrid_encoder_step'


def rmsnorm(x, g):
    xf = x.astype(jnp.float32)
    y = xf * lax.rsqrt(jnp.mean(xf * xf, axis=-1, keepdims=True) + EPS)
    return (y * g.astype(jnp.float32)).astype(x.dtype)


def project(xn, w_in, b_f, g_qa, g_ka, g_qb, g_kb, g_qm):
    b, t, _ = xn.shape
    z = xn @ w_in
    qa, ka, va, qb, kb, vb, fl, qm, gates = jnp.split(z, IN_SPLITS, axis=-1)
    qa = rmsnorm(qa.reshape(b, t, H_A, DH_A), g_qa)
    ka = rmsnorm(ka.reshape(b, t, H_A, DH_A), g_ka)
    va = va.reshape(b, t, H_A, DH_A)
    qb = rmsnorm(qb.reshape(b, t, H_B, DH_B), g_qb)
    kb = rmsnorm(kb.reshape(b, t, H_B, DH_B), g_kb)
    vb = vb.reshape(b, t, H_B, DH_B)
    logf = jax.nn.log_sigmoid(fl.astype(jnp.float32) + b_f.astype(jnp.float32))
    qm = rmsnorm(qm.reshape(b, t, H_M, DH_M), g_qm)
    return qa, ka, va, qb, kb, vb, logf, qm, gates


def rel_bias_lookup(rel_bias, dist):
    bias = rel_bias[jnp.clip(dist, -REL_CLIP, REL_CLIP) + REL_CLIP].astype(jnp.float32)
    return jnp.moveaxis(bias, -1, 0)


def band_attn_prompt(q, k, v, rel_bias):
    b, t, h, d = q.shape
    nc = t // CHUNK
    qc = q.reshape(b, nc, CHUNK, h, d)
    pad = ((0, 0), (A_REACH, 0), (0, 0), (0, 0))
    kp = jnp.pad(k, pad)
    vp = jnp.pad(v, pad)
    rows = jnp.arange(nc)[:, None] * CHUNK + jnp.arange(BAND)[None, :]
    kband = kp[:, rows]
    vband = vp[:, rows]
    s = jnp.einsum('bcqhd,bckhd->bchqk', qc, kband).astype(jnp.float32) * (d ** -0.5)
    dist = jnp.arange(CHUNK)[:, None] + A_REACH - jnp.arange(BAND)[None, :]
    s = s + rel_bias_lookup(rel_bias, dist)
    valid = rows >= A_REACH
    s = jnp.where(valid[None, :, None, None, :], s, -jnp.inf)
    p = jax.nn.softmax(s, axis=-1).astype(v.dtype)
    o = jnp.einsum('bchqk,bckhd->bcqhd', p, vband)
    return o.reshape(b, t, h * d)


def band_attn_sample(q, k_new, v_new, k_cache, v_cache, rel_bias, past_len):
    b, s_len, h, d = q.shape
    n_cache = k_cache.shape[1]
    kk = jnp.concatenate([k_cache, k_new], axis=1)
    vv = jnp.concatenate([v_cache, v_new], axis=1)
    q_pos = past_len + jnp.arange(s_len)
    k_pos = jnp.concatenate([past_len - n_cache + jnp.arange(n_cache), q_pos])
    dist = q_pos[:, None] - k_pos[None, :]
    s = jnp.einsum('bqhd,bkhd->bhqk', q, kk).astype(jnp.float32) * (d ** -0.5)
    s = s + rel_bias_lookup(rel_bias, dist)
    p = jax.nn.softmax(s, axis=-1).astype(vv.dtype)
    o = jnp.einsum('bhqk,bkhd->bqhd', p, vv)
    return o.reshape(b, s_len, h * d)


def forget_attn_prompt(q, k, v, logf):
    b, t, h, d = q.shape
    nb = t // Q_BLOCK
    c = jnp.cumsum(logf, axis=1).transpose(0, 2, 1)
    qblk = q.reshape(b, nb, Q_BLOCK, h, d).transpose(1, 0, 2, 3, 4)
    cblk = c.reshape(b, h, nb, Q_BLOCK).transpose(2, 0, 1, 3)
    k_pos = jnp.arange(t)
    scale = d ** -0.5

    def one_block(args):
        i, qi, ci = args
        s = jnp.einsum('bqhd,bkhd->bhqk', qi, k).astype(jnp.float32) * scale
        s = s + ci[..., :, None] - c[..., None, :]
        q_pos = i * Q_BLOCK + jnp.arange(Q_BLOCK)
        s = jnp.where(k_pos[None, :] <= q_pos[:, None], s, -jnp.inf)
        p = jax.nn.softmax(s, axis=-1).astype(v.dtype)
        return jnp.einsum('bhqk,bkhd->bqhd', p, v)

    o = lax.map(one_block, (jnp.arange(nb), qblk, cblk))
    return o.transpose(1, 0, 2, 3, 4).reshape(b, t, h * d)


def forget_attn_sample(q, k_new, v_new, logf_new, k_cache, v_cache, logf_cache):
    b, s_len, h, d = q.shape
    p_len = k_cache.shape[1]
    kk = jnp.concatenate([k_cache, k_new], axis=1)
    vv = jnp.concatenate([v_cache, v_new], axis=1)
    lf = jnp.concatenate([logf_cache.astype(jnp.float32), logf_new], axis=1)
    c = jnp.cumsum(lf, axis=1).transpose(0, 2, 1)
    cq = c[..., p_len:]
    s = jnp.einsum('bqhd,bkhd->bhqk', q, kk).astype(jnp.float32) * (d ** -0.5)
    s = s + cq[..., :, None] - c[..., None, :]
    q_pos = p_len + jnp.arange(s_len)
    k_pos = jnp.arange(p_len + s_len)
    s = jnp.where(k_pos[None, :] <= q_pos[:, None], s, -jnp.inf)
    p = jax.nn.softmax(s, axis=-1).astype(vv.dtype)
    o = jnp.einsum('bhqk,bkhd->bqhd', p, vv)
    return o.reshape(b, s_len, h * d)


def mem_kv(mem, g_mem, w_mkv, g_km):
    b, n, _ = mem.shape
    mk, mv = jnp.split(rmsnorm(mem, g_mem) @ w_mkv, 2, axis=-1)
    return rmsnorm(mk.reshape(b, n, H_M, DH_M), g_km), mv.reshape(b, n, H_M, DH_M)


def mem_attn(q, mk, mv):
    b, t, h, d = q.shape
    s = jnp.einsum('bqhd,bmhd->bhqm', q, mk).astype(jnp.float32) * (d ** -0.5)
    p = jax.nn.softmax(s, axis=-1).astype(mv.dtype)
    o = jnp.einsum('bhqm,bmhd->bqhd', p, mv)
    return o.reshape(b, t, h * d)


def gated_merge(o_a, o_b, o_m, gates, w_pa, w_pb, w_pm, w_o):
    g_a, g_b, g_m = jnp.split(jax.nn.sigmoid(gates), N_BRANCH, axis=-1)
    h = g_a * (o_a @ w_pa) + g_b * (o_b @ w_pb) + g_m * (o_m @ w_pm)
    return h @ w_o


def sq_relu_mlp(x, g_ffn, w_up, w_down):
    h = jax.nn.relu(rmsnorm(x, g_ffn) @ w_up)
    return (h * h) @ w_down


def setup_inputs(seed: int = 0) -> dict:
    key = jax.random.key(seed)
    ks = iter(jax.random.split(key, 40))
    f32 = jnp.float32
    L = DEPTH
    a_cache = min(A_REACH, PAST_LEN)

    def nrm(shape, scale=1.0):
        return scale * jax.random.normal(next(ks), shape, f32)

    def gain(n):
        return 1.0 + 0.05 * nrm((L, n))

    return {
        'x_prompt': nrm((BATCH, SEQ, D_MODEL)),
        'x_sample': nrm((DEC_BATCH, DEC_SEQ, D_MODEL)),
        'mem_prompt': nrm((BATCH, N_MEM, D_MODEL)),
        'cache_a_k': nrm((L, DEC_BATCH, a_cache, H_A, DH_A)),
        'cache_a_v': nrm((L, DEC_BATCH, a_cache, H_A, DH_A)),
        'cache_b_k': nrm((L, DEC_BATCH, PAST_LEN, H_B, DH_B)),
        'cache_b_v': nrm((L, DEC_BATCH, PAST_LEN, H_B, DH_B)),
        'cache_b_logf': jax.nn.log_sigmoid(3.0 + 1.5 * nrm((L, DEC_BATCH, PAST_LEN, H_B))),
        'cache_mem_k': nrm((L, DEC_BATCH, N_MEM, H_M, DH_M)),
        'cache_mem_v': nrm((L, DEC_BATCH, N_MEM, H_M, DH_M)),
        'g_mix': gain(D_MODEL),
        'w_in': nrm((L, D_MODEL, D_IN), D_MODEL ** -0.5),
        'b_f': 1.0 + 5.0 * jax.random.uniform(next(ks), (L, H_B), f32),
        'g_qa': gain(DH_A),
        'g_ka': gain(DH_A),
        'g_qb': gain(DH_B),
        'g_kb': gain(DH_B),
        'g_qm': gain(DH_M),
        'g_km': gain(DH_M),
        'rel_bias': nrm((L, N_REL, H_A), 0.5),
        'g_mem': gain(D_MODEL),
        'w_mkv': nrm((L, D_MODEL, 2 * W_M), D_MODEL ** -0.5),
        'w_pa': nrm((L, W_A, D_MODEL), W_A ** -0.5),
        'w_pb': nrm((L, W_B, D_MODEL), W_B ** -0.5),
        'w_pm': nrm((L, W_M, D_MODEL), W_M ** -0.5),
        'w_o': nrm((L, D_MODEL, D_MODEL), D_MODEL ** -0.5),
        'g_ffn': gain(D_MODEL),
        'w_up': nrm((L, D_MODEL, D_FF), D_MODEL ** -0.5),
        'w_down': nrm((L, D_FF, D_MODEL), D_FF ** -0.5),
    }


def reference(x_prompt, x_sample, mem_prompt, cache_a_k, cache_a_v, cache_b_k, cache_b_v, cache_b_logf,
              cache_mem_k, cache_mem_v, g_mix, w_in, b_f, g_qa, g_ka, g_qb, g_kb, g_qm, g_km, rel_bias,
              g_mem, w_mkv, w_pa, w_pb, w_pm, w_o, g_ffn, w_up, w_down):
    past_len = cache_b_k.shape[2]
    keep_p = min(A_REACH, x_prompt.shape[1])
    xp = x_prompt
    xs = x_sample
    ak_p, av_p, bk_p, bv_p, blf_p, mk_p, mv_p = [], [], [], [], [], [], []
    ak_s, av_s, bk_s, bv_s, blf_s = [], [], [], [], []
    for l in range(DEPTH):
        xn = rmsnorm(xp, g_mix[l])
        qa, ka, va, qb, kb, vb, lf, qm, gates = project(xn, w_in[l], b_f[l], g_qa[l], g_ka[l], g_qb[l], g_kb[l], g_qm[l])
        mk, mv = mem_kv(mem_prompt, g_mem[l], w_mkv[l], g_km[l])
        o_a = band_attn_prompt(qa, ka, va, rel_bias[l])
        o_b = forget_attn_prompt(qb, kb, vb, lf)
        o_m = mem_attn(qm, mk, mv)
        xp = xp + gated_merge(o_a, o_b, o_m, gates, w_pa[l], w_pb[l], w_pm[l], w_o[l])
        xp = xp + sq_relu_mlp(xp, g_ffn[l], w_up[l], w_down[l])
        ak_p.append(ka[:, -keep_p:])
        av_p.append(va[:, -keep_p:])
        bk_p.append(kb)
        bv_p.append(vb)
        blf_p.append(lf)
        mk_p.append(mk)
        mv_p.append(mv)
        xn = rmsnorm(xs, g_mix[l])
        qa, ka, va, qb, kb, vb, lf, qm, gates = project(xn, w_in[l], b_f[l], g_qa[l], g_ka[l], g_qb[l], g_kb[l], g_qm[l])
        o_a = band_attn_sample(qa, ka, va, cache_a_k[l], cache_a_v[l], rel_bias[l], past_len)
        o_b = forget_attn_sample(qb, kb, vb, lf, cache_b_k[l], cache_b_v[l], cache_b_logf[l])
        o_m = mem_attn(qm, cache_mem_k[l], cache_mem_v[l])
        xs = xs + gated_merge(o_a, o_b, o_m, gates, w_pa[l], w_pb[l], w_pm[l], w_o[l])
        xs = xs + sq_relu_mlp(xs, g_ffn[l], w_up[l], w_down[l])
        ak_s.append(ka)
        av_s.append(va)
        bk_s.append(kb)
        bv_s.append(vb)
        blf_s.append(lf)
    new_a_k_prompt = jnp.stack(ak_p)
    new_a_v_prompt = jnp.stack(av_p)
    new_b_k_prompt = jnp.stack(bk_p)
    new_b_v_prompt = jnp.stack(bv_p)
    new_b_logf_prompt = jnp.stack(blf_p)
    new_mem_k_prompt = jnp.stack(mk_p)
    new_mem_v_prompt = jnp.stack(mv_p)
    new_a_k_sample = jnp.stack(ak_s)
    new_a_v_sample = jnp.stack(av_s)
    new_b_k_sample = jnp.stack(bk_s)
    new_b_v_sample = jnp.stack(bv_s)
    new_b_logf_sample = jnp.stack(blf_s)
    return (xp, xs, new_a_k_prompt, new_a_v_prompt, new_b_k_prompt, new_b_v_prompt, new_b_logf_prompt,
            new_mem_k_prompt, new_mem_v_prompt, new_a_k_sample, new_a_v_sample, new_b_k_sample,
            new_b_v_sample, new_b_logf_sample)
```

```cpp
#include <hip/hip_runtime.h>
#include <hip/hip_cooperative_groups.h>
#include <cstdio>
#include <cstdint>
namespace cg = cooperative_groups;
#ifndef DUPMASK
#define DUPMASK 0
#endif
namespace pg8 {
#define PG8_LAS __attribute__((address_space(3)))
typedef unsigned short bf16_t;
typedef short bf16x8 __attribute__((ext_vector_type(8)));
typedef float f32x4 __attribute__((ext_vector_type(4)));
typedef unsigned u32x4 __attribute__((ext_vector_type(4)));
constexpr int BM = 256, BK = 64, HALF = 128, HTB = HALF * BK * 2  , STAGE_BYTES = 8 * HTB, NXCD = 8, WGM = 8;

__host__ __device__ __forceinline__ int lds_byte(int r, int c) { const int st = (r >> 4) * 2 + (c >> 5), rr = r & 15, cc = c & 31, ob = rr * 64 + cc * 2; return st * 1024 + (ob ^ (((ob >> 9) & 1) << 5)); }
__host__ __device__ __forceinline__ void stage_rc(int b, int& R, int& C) { const int st = b / 1024, sb = b % 1024, swz = sb ^ (((sb >> 9) & 1) << 5); R = (st >> 1) * 16 + swz / 64; C = (st & 1) * 32 + (swz % 64) / 2; }
__host__ __device__ __forceinline__ int perm32(int rho) { const int n = rho >> 4, i = rho & 15; return 8 * (i >> 2) + 4 * n + (i & 3); }

struct Unit { int pm, pn; };
struct Gemm { const bf16_t* A; const bf16_t* Bt; int M, N, K; };

struct StaticOrder {
    int nM, nN, nwg, G, c;
    __host__ __device__ void init(int M, int N, int G_, int c_) { nM = M / BM; nN = N / BM; nwg = nM * nN; G = G_; c = c_; }
    __host__ __device__ bool next(int i, Unit& u) const {
        const long L = (long)i * G + c; if (L >= nwg) return false;
        int wgid = (int)L; { const int q = nwg / NXCD, r = nwg % NXCD, xcd = wgid % NXCD, off = wgid / NXCD; wgid = (xcd < r ? xcd * (q + 1) : r * (q + 1) + (xcd - r) * q) + off; }
        const int nig = WGM * nN, gid = wgid / nig, fm = gid * WGM, gsz = (nM - fm) < WGM ? (nM - fm) : WGM;
        u.pm = fm + ((wgid % nig) % gsz); u.pn = (wgid % nig) / gsz; return true;
    }
    __device__ __forceinline__ void a_ready(const Unit&) const {}
    __device__ __forceinline__ void done(const Unit&) const {}
};

__device__ __forceinline__ unsigned cvt_pk_bf16(float lo, float hi) { unsigned r; asm volatile("v_cvt_pk_bf16_f32 %0, %1, %2" : "=v"(r) : "v"(lo), "v"(hi)); return r; }
typedef float f32x2 __attribute__((ext_vector_type(2)));
template <class Epi, class Sched, bool ALIGN_EPI = false, bool SP2 = false>
__device__ __forceinline__ void gemm_phase(PG8_LAS unsigned char* lds, const Gemm g, const Sched& S, const Epi& E) {
    const int tid = threadIdx.x, wid = __builtin_amdgcn_readfirstlane(tid >> 6), lane = tid & 63, wr = wid >> 2, wc = wid & 3, fr = lane & 15, fq = lane >> 4;
    const int K = g.K, nt = K / BK;
    unsigned voffA[2], voffB[2];
#pragma unroll
    for (int i = 0; i < 2; ++i) { int R, C; stage_rc(tid * 16 + i * 8192, R, C); const int Rb = Epi::PERM ? ((R & ~31) + perm32(R & 31)) : R;
        voffA[i] = (unsigned)(R * K + C) * 2u; voffB[i] = (unsigned)(Rb * K + C) * 2u; }
    const size_t kstep = (size_t)(BK * 2);
    const size_t hstep = (size_t)HALF * K * 2;
    const size_t tstep = 2 * hstep;
    const unsigned ldsw = (unsigned)wid * 1024u;
    const int aoff = lds_byte(wr * 64 + fr, fq * 8), boff = lds_byte(wc * 32 + fr, fq * 8);
#define PG8_SA(b, h) (((b) * 2 + (h)) * HTB)
#define PG8_SB(b, h) ((4 + (b) * 2 + (h)) * HTB)
#define PG8_STAGE(bufoff, gbase, voff) do { _Pragma("unroll") for (int _i = 0; _i < 2; ++_i) \
        __builtin_amdgcn_global_load_lds((const unsigned*)((const char*)(gbase) + (voff)[_i]), (PG8_LAS unsigned*)(lds + (bufoff) + ldsw + _i * 8192), 16, 0, 0); } while (0)
#define PG8_LDA(dst, b, h) do { _Pragma("unroll") for (int m = 0; m < 4; ++m) _Pragma("unroll") for (int k = 0; k < 2; ++k) dst[m][k] = *(const PG8_LAS bf16x8*)(lds + PG8_SA(b, h) + aoff + m * 2048 + k * 1024); } while (0)
#define PG8_LDB(dst, b, h) do { _Pragma("unroll") for (int n = 0; n < 2; ++n) _Pragma("unroll") for (int k = 0; k < 2; ++k) dst[n][k] = *(const PG8_LAS bf16x8*)(lds + PG8_SB(b, h) + boff + n * 2048 + k * 1024); } while (0)
#define PG8_MMA(ai, bj, At, Bt) do { __builtin_amdgcn_s_setprio(1); _Pragma("unroll") for (int m = 0; m < 4; ++m) _Pragma("unroll") for (int n = 0; n < 2; ++n) _Pragma("unroll") for (int k = 0; k < 2; ++k) \
        acc[ai][bj][m][n] = __builtin_amdgcn_mfma_f32_16x16x32_bf16(Bt[n][k], At[m][k], acc[ai][bj][m][n], 0, 0, 0); __builtin_amdgcn_s_setprio(0); } while (0)
#define PG8_WAIT_V(n) asm volatile("s_waitcnt vmcnt(" #n ")" ::: "memory")
#define PG8_WAIT_L(n) asm volatile("s_waitcnt lgkmcnt(" #n ")" ::: "memory")
#define PG8_BAR __builtin_amdgcn_s_barrier()
#define PG8_SCHED __builtin_amdgcn_sched_barrier(0)
    Unit cur, nxt; int ui = 0;
    if (!S.next(0, cur)) return;
    f32x4 acc[2][2][4][2];
#pragma unroll
    for (int a = 0; a < 2; ++a)
#pragma unroll
        for (int b = 0; b < 2; ++b)
#pragma unroll
            for (int m = 0; m < 4; ++m)
#pragma unroll
                for (int n = 0; n < 2; ++n) acc[a][b][m][n] = (f32x4){0.f, 0.f, 0.f, 0.f};
    bf16x8 At[4][2], B0[2][2], B1[2][2];
    const char* cA = (const char*)g.A + (size_t)cur.pm * tstep; const char* cB = (const char*)g.Bt + (size_t)cur.pn * tstep;
    S.a_ready(cur);
    if constexpr (SP2) {
        PG8_STAGE(PG8_SB(0, 0), cB, voffB); PG8_STAGE(PG8_SB(0, 1), cB + hstep, voffB); PG8_STAGE(PG8_SA(0, 0), cA, voffA); PG8_STAGE(PG8_SA(0, 1), cA + hstep, voffA);
        if (wr == 1) PG8_BAR;
        PG8_WAIT_V(2); PG8_BAR;
        PG8_STAGE(PG8_SB(1, 0), cB + kstep, voffB); PG8_STAGE(PG8_SA(1, 0), cA + kstep, voffA); PG8_STAGE(PG8_SB(1, 1), cB + hstep + kstep, voffB);
        PG8_WAIT_V(6); PG8_BAR;
    } else {
        PG8_STAGE(PG8_SB(0, 0), cB, voffB); PG8_STAGE(PG8_SA(0, 0), cA, voffA); PG8_STAGE(PG8_SB(0, 1), cB + hstep, voffB); PG8_STAGE(PG8_SA(0, 1), cA + hstep, voffA);
        if (wr == 1) PG8_BAR;
        PG8_WAIT_V(4); PG8_BAR;
        PG8_STAGE(PG8_SB(1, 0), cB + kstep, voffB); PG8_STAGE(PG8_SA(1, 0), cA + kstep, voffA); PG8_STAGE(PG8_SB(1, 1), cB + hstep + kstep, voffB);
        PG8_WAIT_V(6); PG8_BAR;
    }
    for (;;) {
        const bool has_next = S.next(ui + 1, nxt);
        const char* nA = has_next ? (const char*)g.A + (size_t)nxt.pm * tstep : cA; const char* nB = has_next ? (const char*)g.Bt + (size_t)nxt.pn * tstep : cB;
        for (int t = 0; t < nt; t += 2) {
            if constexpr (Epi::MID) { if (t == 8 || t == 16) E.mid(acc, cur, t, wr, wc, fr, fq); }
            const bool last = (t == nt - 2);
            const char* a1 = cA + (size_t)(t + 1) * kstep;
            const char* a2 = last ? nA : cA + (size_t)(t + 2) * kstep; const char* b2 = last ? nB : cB + (size_t)(t + 2) * kstep;
            const char* a3 = a2 + kstep; const char* b3 = b2 + kstep;
            if (last && has_next) S.a_ready(nxt);
            if constexpr (SP2) {
            PG8_LDB(B0, 0, 0); PG8_LDB(B1, 0, 1); PG8_SCHED; PG8_LDA(At, 0, 0); PG8_STAGE(PG8_SA(1, 1), a1 + hstep, voffA);
            PG8_WAIT_V(8); PG8_WAIT_L(0); PG8_BAR; PG8_MMA(0, 0, At, B0); PG8_MMA(0, 1, At, B1); PG8_BAR; PG8_SCHED;
            PG8_LDA(At, 0, 1); PG8_STAGE(PG8_SB(0, 0), b2, voffB); PG8_STAGE(PG8_SB(0, 1), b2 + hstep, voffB); PG8_STAGE(PG8_SA(0, 0), a2, voffA);
            PG8_WAIT_V(8); PG8_WAIT_L(0); PG8_BAR; PG8_MMA(1, 0, At, B0); PG8_MMA(1, 1, At, B1); PG8_BAR; PG8_SCHED;
            PG8_LDB(B0, 1, 0); PG8_LDB(B1, 1, 1); PG8_SCHED; PG8_LDA(At, 1, 0); PG8_STAGE(PG8_SA(0, 1), a2 + hstep, voffA);
            PG8_WAIT_V(8); PG8_WAIT_L(0); PG8_BAR; PG8_MMA(0, 0, At, B0); PG8_MMA(0, 1, At, B1); PG8_BAR; PG8_SCHED;
            PG8_LDA(At, 1, 1); PG8_STAGE(PG8_SB(1, 0), b3, voffB); PG8_STAGE(PG8_SB(1, 1), b3 + hstep, voffB); PG8_STAGE(PG8_SA(1, 0), a3, voffA);
            PG8_WAIT_V(8); PG8_WAIT_L(0); PG8_BAR; PG8_MMA(1, 0, At, B0); PG8_MMA(1, 1, At, B1); PG8_BAR; PG8_SCHED;
            } else {
            PG8_LDB(B0, 0, 0); PG8_SCHED; PG8_LDA(At, 0, 0); PG8_STAGE(PG8_SA(1, 1), a1 + hstep, voffA);
            PG8_WAIT_L(8); PG8_BAR; PG8_WAIT_L(0); PG8_MMA(0, 0, At, B0); PG8_BAR; PG8_SCHED;
            PG8_LDB(B1, 0, 1); PG8_STAGE(PG8_SB(0, 0), b2, voffB);
            PG8_BAR; PG8_WAIT_L(0); PG8_MMA(0, 1, At, B1); PG8_BAR;
            PG8_LDA(At, 0, 1); PG8_STAGE(PG8_SA(0, 0), a2, voffA);
            PG8_BAR; PG8_WAIT_L(0); PG8_MMA(1, 0, At, B0); PG8_BAR; PG8_SCHED;
            PG8_STAGE(PG8_SB(0, 1), b2 + hstep, voffB);
            PG8_WAIT_V(6); PG8_BAR; PG8_MMA(1, 1, At, B1); PG8_BAR;
            PG8_LDB(B0, 1, 0); PG8_SCHED; PG8_LDA(At, 1, 0); PG8_STAGE(PG8_SA(0, 1), a2 + hstep, voffA);
            PG8_WAIT_L(8); PG8_BAR; PG8_WAIT_L(0); PG8_MMA(0, 0, At, B0); PG8_BAR; PG8_SCHED;
            PG8_LDB(B1, 1, 1); PG8_STAGE(PG8_SB(1, 0), b3, voffB);
            PG8_BAR; PG8_WAIT_L(0); PG8_MMA(0, 1, At, B1); PG8_BAR;
            PG8_LDA(At, 1, 1); PG8_STAGE(PG8_SA(1, 0), a3, voffA);
            PG8_BAR; PG8_WAIT_L(0); PG8_MMA(1, 0, At, B0); PG8_BAR; PG8_SCHED;
            PG8_STAGE(PG8_SB(1, 1), b3 + hstep, voffB);
            PG8_WAIT_V(6); PG8_BAR; PG8_MMA(1, 1, At, B1); PG8_BAR;
            }
        }
        if constexpr (ALIGN_EPI) { if (wr == 0) PG8_BAR; }
        if constexpr (!Epi::AFTER_DRAIN) { E(acc, cur, wr, wc, fr, fq); S.done(cur); }
        if (!has_next) break;
#pragma unroll
        for (int a = 0; a < 2; ++a)
#pragma unroll
            for (int b = 0; b < 2; ++b)
#pragma unroll
                for (int m = 0; m < 4; ++m)
#pragma unroll
                    for (int n = 0; n < 2; ++n) acc[a][b][m][n] = (f32x4){0.f, 0.f, 0.f, 0.f};
        cur = nxt; cA = nA; cB = nB; ++ui;
        if constexpr (ALIGN_EPI) { if (wr == 1) PG8_BAR; }
    }
    PG8_WAIT_V(0);
    if constexpr (!ALIGN_EPI) { if (wr == 0) PG8_BAR; }
    PG8_BAR;
    if constexpr (Epi::AFTER_DRAIN) { E.fused(acc, cur, wr, wc, fr, fq, lds, wid, lane); S.done(cur); }
#undef PG8_SA
#undef PG8_SB
#undef PG8_STAGE
#undef PG8_LDA
#undef PG8_LDB
#undef PG8_MMA
#undef PG8_WAIT_V
#undef PG8_WAIT_L
#undef PG8_BAR
#undef PG8_SCHED
}
}

#define LAS __attribute__((address_space(3)))
typedef unsigned short bf16_t;
typedef short bf16x8 __attribute__((ext_vector_type(8)));
typedef short s16x4 __attribute__((ext_vector_type(4)));
typedef float f32x4 __attribute__((ext_vector_type(4)));
typedef float f32x16 __attribute__((ext_vector_type(16)));
typedef unsigned u32x4 __attribute__((ext_vector_type(4)));
typedef unsigned u32x2 __attribute__((ext_vector_type(2)));
typedef float f32x2 __attribute__((ext_vector_type(2)));
typedef __bf16 bf16x2_t __attribute__((ext_vector_type(2)));

constexpr int DM = 1024, SEQ = 4096, NBATCH = 4, MP = NBATCH * SEQ, SBATCH = 32, SSEQ = 16, MS = SBATCH * SSEQ, MT = MP + MS;
constexpr int PAST = 2048, ACACHE = 512, NMEM = 256, DFF = 4096, NIN = 6656, DIN = 6664, KEEP = 512;
constexpr float EPS = 1e-6f, LOG2E = 1.4426950408889634f;
constexpr int SLEN = PAST + SSEQ;

constexpr size_t O_YP = 0, O_YS = O_YP + (size_t)MP * DM, O_AKP = O_YS + (size_t)MS * DM, O_AVP = O_AKP + (size_t)NBATCH * KEEP * 512,
    O_BKP = O_AVP + (size_t)NBATCH * KEEP * 512, O_BVP = O_BKP + (size_t)MP * 512, O_LFP = O_BVP + (size_t)MP * 512, O_MKP = O_LFP + (size_t)MP * 8,
    O_MVP = O_MKP + (size_t)NBATCH * NMEM * 512, O_AKS = O_MVP + (size_t)NBATCH * NMEM * 512, O_AVS = O_AKS + (size_t)MS * 512, O_BKS = O_AVS + (size_t)MS * 512,
    O_BVS = O_BKS + (size_t)MS * 512, O_LFS = O_BVS + (size_t)MS * 512, O_END = O_LFS + (size_t)MS * 8;
static_assert(O_END == 38408192, "output size");

constexpr size_t al256(size_t x) { return (x + 255) & ~(size_t)255; }
constexpr size_t WS_CTL = 0, WS_BAR = 4096  , WS_RSTD1 = 20480, WS_RSTDM = WS_RSTD1 + MT * 4  , WS_SSQ2 = al256(WS_RSTDM + 1024 * 4), WS_PARTQ = al256(WS_SSQ2 + MT * 4),
    WS_PARTK = al256(WS_PARTQ + (size_t)MT * 8 * 4), WS_CP = al256(WS_PARTK + 1024 * 8 * 4), WS_CS = al256(WS_CP + 32 * 4096 * 4), WS_MKRAW = al256(WS_CS + 256 * SLEN * 4),
    WS_MVB = al256(WS_MKRAW + 1024 * 512 * 4), WS_WIN = al256(WS_MVB + 1024 * 512 * 2), WS_WMKV = WS_WIN + (size_t)NIN * 1024 * 2  ,
    WS_WPC = al256(WS_WMKV + 1024 * 1024 * 2)  , WS_WO = al256(WS_WPC + 1024 * 1536 * 2),
    WS_WUP = al256(WS_WO + 1024 * 1024 * 2), WS_WDN = al256(WS_WUP + (size_t)4096 * 1024 * 2), WS_XB = al256(WS_WDN + (size_t)4096 * 1024 * 2),
    WS_MB = WS_XB + (size_t)MT * 1024 * 2  , WS_OC = al256(WS_MB + 1024 * 1024 * 2)  ,
    WS_H = al256(WS_OC + (size_t)MT * 1536 * 2), WS_X1B = al256(WS_H + (size_t)MT * 1024 * 2),
    WS_QA = al256(WS_X1B + (size_t)MT * 1024 * 2), WS_KA = al256(WS_QA + (size_t)MT * 512 * 2), WS_VA = al256(WS_KA + (size_t)MT * 512 * 2), WS_QB = al256(WS_VA + (size_t)MT * 512 * 2),
    WS_KB = al256(WS_QB + (size_t)MT * 512 * 2), WS_VB = al256(WS_KB + (size_t)MT * 512 * 2), WS_QM = al256(WS_VB + (size_t)MT * 512 * 2), WS_GT = al256(WS_QM + (size_t)MT * 512 * 2),
    WS_ZEND = al256(WS_GT + (size_t)MT * 3072 * 2), WS_HF = WS_QA  , WS_END = WS_ZEND;
static_assert(WS_HF + (size_t)MT * 4096 * 2 <= WS_ZEND, "HF overlay fits");
static_assert(WS_RSTDM % 256 == 0 && WS_WMKV % 256 == 0 && WS_MB % 256 == 0, "contiguous tails stay aligned");

struct Args { const float* in[29]; float* out; unsigned char* ws; int ph_lo, ph_hi; };

__device__ __forceinline__ unsigned f2bf(float f) { unsigned u = __builtin_bit_cast(unsigned, f); return (u + 0x7fffu + ((u >> 16) & 1u)) >> 16; }
__device__ __forceinline__ unsigned pk2(float lo, float hi) { f32x2 v = {lo, hi}; bf16x2_t b = __builtin_convertvector(v, bf16x2_t); return __builtin_bit_cast(unsigned, b); }
__device__ __forceinline__ float wave_sum(float v) {
#pragma unroll
    for (int o = 1; o < 64; o <<= 1) v += __shfl_xor(v, o);
    return v;
}
__device__ __forceinline__ const float* opq(const float* p) { asm volatile("" : "+s"(p)); return p; }
__device__ __forceinline__ float fast_sigmoid(float x) { return __builtin_amdgcn_rcpf(1.0f + __builtin_amdgcn_exp2f(-x * LOG2E)); }

typedef pg8::f32x4 af4;
#define EPI_ARGS const af4 (&acc)[2][2][4][2], const pg8::Unit& u, int wr, int wc, int fr, int fq

struct EpiIn {
    static constexpr bool PERM = true, AFTER_DRAIN = false, MID = false;
    const float* rstd; float* out; unsigned char* ws; const float *g_qa, *g_ka, *g_qb, *g_kb, *g_qm;
    __device__ __forceinline__ void mkv(EPI_ARGS) const {
        const int pn = u.pn - 26, pm = u.pm; const int rbase = pm * 256 + wr * 64 + fr - MT;
        const float* rstdm = rstd + MT; const int colS = (pn & 1) * 256 + wc * 64 + 8 * fq;
        float rsv[2][4];
#pragma unroll
        for (int ai = 0; ai < 2; ++ai)
#pragma unroll
            for (int m = 0; m < 4; ++m) rsv[ai][m] = rstdm[rbase + ai * 128 + m * 16];
        float* mk = (float*)(ws + WS_MKRAW); float* part = (float*)(ws + WS_PARTK); bf16_t* mvb = (bf16_t*)(ws + WS_MVB); float* mvo = out + O_MVP;
#pragma unroll
        for (int ai = 0; ai < 2; ++ai)
#pragma unroll
            for (int m = 0; m < 4; ++m) { const int r = rbase + ai * 128 + m * 16; const float rs = rsv[ai][m]; float ss = 0.f;
#pragma unroll
                for (int bj = 0; bj < 2; ++bj) { const af4 a = acc[ai][bj][m][0] * rs, b = acc[ai][bj][m][1] * rs; const size_t o = (size_t)r * 512 + colS + bj * 32;
                    if (pn < 2) { ss += (a[0] * a[0] + a[1] * a[1]) + (a[2] * a[2] + a[3] * a[3]) + (b[0] * b[0] + b[1] * b[1]) + (b[2] * b[2] + b[3] * b[3]); *(af4*)(mk + o) = a; *(af4*)(mk + o + 4) = b; }
                    else { *(af4*)(mvo + o) = a; *(af4*)(mvo + o + 4) = b; u32x4 w; w.x = pk2(a[0], a[1]); w.y = pk2(a[2], a[3]); w.z = pk2(b[0], b[1]); w.w = pk2(b[2], b[3]); *(u32x4*)(mvb + o) = w; } }
                if (pn < 2) { ss += __shfl_xor(ss, 16); ss += __shfl_xor(ss, 32); if (fq == 0) part[(size_t)r * 8 + (pn & 1) * 4 + wc] = ss; } }
    }
    __device__ __forceinline__ void operator()(EPI_ARGS) const {
        const int pn = u.pn, pm = u.pm;
        const int rbase = pm * 256 + wr * 64 + fr;
        if (pn >= 26) { mkv(acc, u, wr, wc, fr, fq); return; }
        float rsv[2][4];
#pragma unroll
        for (int ai = 0; ai < 2; ++ai)
#pragma unroll
            for (int m = 0; m < 4; ++m) rsv[ai][m] = rstd[rbase + ai * 128 + m * 16];
        if (pn >= 14) {
            bf16_t* G = (bf16_t*)(ws + WS_GT);
            const int col0 = (pn - 14) * 256 + wc * 32 + 8 * fq;
#pragma unroll
            for (int ai = 0; ai < 2; ++ai)
#pragma unroll
                for (int m = 0; m < 4; ++m) { const int r = rbase + ai * 128 + m * 16; const float rs = rsv[ai][m]; bf16_t* rowp = G + (size_t)r * 3072 + col0;
#pragma unroll
                    for (int bj = 0; bj < 2; ++bj) { const af4 v0 = acc[ai][bj][m][0] * rs, v1 = acc[ai][bj][m][1] * rs; u32x4 w;
                        w.x = pk2(fast_sigmoid(v0[0]), fast_sigmoid(v0[1])); w.y = pk2(fast_sigmoid(v0[2]), fast_sigmoid(v0[3]));
                        w.z = pk2(fast_sigmoid(v1[0]), fast_sigmoid(v1[1])); w.w = pk2(fast_sigmoid(v1[2]), fast_sigmoid(v1[3]));
                        *(u32x4*)(rowp + bj * 128) = w; } }
            return;
        }
        const int sec = pn >> 1;
        const int colS = (pn & 1) * 256 + wc * 64 + 8 * fq;
        if (sec == 6) {
            bf16_t* Q = (bf16_t*)(ws + WS_QM); float* part = (float*)(ws + WS_PARTQ);
            const float qs = 0.08838834764831845f * LOG2E;
            const int dd0 = (wc & 1) * 64 + 8 * fq;
            af4 g[2][2];
#pragma unroll
            for (int bj = 0; bj < 2; ++bj)
#pragma unroll
                for (int n = 0; n < 2; ++n) g[bj][n] = *(const af4*)(g_qm + dd0 + 32 * bj + 4 * n) * qs;
#pragma unroll
            for (int ai = 0; ai < 2; ++ai)
#pragma unroll
                for (int m = 0; m < 4; ++m) { const int r = rbase + ai * 128 + m * 16; const float rs = rsv[ai][m]; float ss = 0.f; bf16_t* rowp = Q + (size_t)r * 512 + colS;
#pragma unroll
                    for (int bj = 0; bj < 2; ++bj) { const af4 v0 = acc[ai][bj][m][0] * rs, v1 = acc[ai][bj][m][1] * rs;
                        ss += (v0[0] * v0[0] + v0[1] * v0[1]) + (v0[2] * v0[2] + v0[3] * v0[3]) + (v1[0] * v1[0] + v1[1] * v1[1]) + (v1[2] * v1[2] + v1[3] * v1[3]);
                        const af4 a = v0 * g[bj][0], b = v1 * g[bj][1]; u32x4 w; w.x = pk2(a[0], a[1]); w.y = pk2(a[2], a[3]); w.z = pk2(b[0], b[1]); w.w = pk2(b[2], b[3]);
                        *(u32x4*)(rowp + bj * 32) = w; }
                    ss += __shfl_xor(ss, 16); ss += __shfl_xor(ss, 32);
                    if (fq == 0) part[(size_t)r * 8 + (pn & 1) * 4 + wc] = ss; }
            return;
        }
        const bool normed = (sec == 0 || sec == 1 || sec == 3 || sec == 4);
        const bool isq = (sec == 0 || sec == 3);
        const float *gA = opq(g_qa), *gB = opq(g_ka), *gC = opq(g_qb), *gD = opq(g_kb);
        const float* gp = sec == 0 ? gA : sec == 1 ? gB : sec == 3 ? gC : gD;
        bf16_t* B = (bf16_t*)(ws + (sec == 0 ? WS_QA : sec == 1 ? WS_KA : sec == 2 ? WS_VA : sec == 3 ? WS_QB : sec == 4 ? WS_KB : WS_VB));
        af4 g[2][2];
#pragma unroll
        for (int bj = 0; bj < 2; ++bj)
#pragma unroll
            for (int n = 0; n < 2; ++n) g[bj][n] = normed ? *(const af4*)(gp + 8 * fq + 32 * bj + 4 * n) * (isq ? 0.125f * LOG2E : 1.0f) : (af4){1.f, 1.f, 1.f, 1.f};
        float* fo = nullptr; long frow_off = 0;
        const bool sample = pm >= 64;
        if (sec == 1 || sec == 2) {
            if (sample) { fo = out + (sec == 1 ? O_AKS : O_AVS); frow_off = -(long)MP; }
            else if ((pm & 15) >= 14) { fo = out + (sec == 1 ? O_AKP : O_AVP); frow_off = -(long)((pm >> 4) * 4096 + 3584) + (long)(pm >> 4) * 512; }
        } else if (sec == 4 || sec == 5) {
            if (sample) { fo = out + (sec == 4 ? O_BKS : O_BVS); frow_off = -(long)MP; } else { fo = out + (sec == 4 ? O_BKP : O_BVP); frow_off = 0; }
        }
#pragma unroll
        for (int ai = 0; ai < 2; ++ai)
#pragma unroll
            for (int m = 0; m < 4; ++m) { const int r = rbase + ai * 128 + m * 16; const float rs = rsv[ai][m];
                af4 v[2][2]; float ss = 0.f;
#pragma unroll
                for (int bj = 0; bj < 2; ++bj)
#pragma unroll
                    for (int n = 0; n < 2; ++n) { v[bj][n] = acc[ai][bj][m][n] * rs; const af4 t = v[bj][n]; ss += (t[0] * t[0] + t[1] * t[1]) + (t[2] * t[2] + t[3] * t[3]); }
                float rn = 1.0f;
                if (normed) { ss += __shfl_xor(ss, 16); ss += __shfl_xor(ss, 32); rn = 1.0f / sqrtf(ss * (1.0f / 64.0f) + EPS); }
                bf16_t* rowp = B + (size_t)r * 512 + colS;
#pragma unroll
                for (int bj = 0; bj < 2; ++bj) { const af4 a = v[bj][0] * rn * g[bj][0], b = v[bj][1] * rn * g[bj][1];
                    u32x4 w; w.x = pk2(a[0], a[1]); w.y = pk2(a[2], a[3]); w.z = pk2(b[0], b[1]); w.w = pk2(b[2], b[3]);
                    *(u32x4*)(rowp + bj * 32) = w;
                    if (fo) { float* fp = fo + (size_t)((long)r + frow_off) * 512 + colS + bj * 32; *(af4*)fp = a; *(af4*)(fp + 4) = b; } } }
    }
};

#ifndef HOOKF
#define HOOKF 3
#endif
struct EpiMergeH {
    static constexpr bool PERM = true, AFTER_DRAIN = false, MID = true;
    unsigned char* ws;
    static __device__ __forceinline__ void unpack8(const u32x4 gw, af4& a, af4& b) {
        a[0] = __uint_as_float(gw.x << 16); a[1] = __uint_as_float(gw.x & 0xffff0000u); a[2] = __uint_as_float(gw.y << 16); a[3] = __uint_as_float(gw.y & 0xffff0000u);
        b[0] = __uint_as_float(gw.z << 16); b[1] = __uint_as_float(gw.z & 0xffff0000u); b[2] = __uint_as_float(gw.w << 16); b[3] = __uint_as_float(gw.w & 0xffff0000u);
#pragma unroll
        for (int i = 0; i < 4; ++i) { a[i] = fmaxf(a[i], 1e-20f); b[i] = fmaxf(b[i], 1e-20f); }
    }
    static __device__ __forceinline__ void unpack8raw(const u32x4 gw, af4& a, af4& b) {
        a[0] = __uint_as_float(gw.x << 16); a[1] = __uint_as_float(gw.x & 0xffff0000u); a[2] = __uint_as_float(gw.y << 16); a[3] = __uint_as_float(gw.y & 0xffff0000u);
        b[0] = __uint_as_float(gw.z << 16); b[1] = __uint_as_float(gw.z & 0xffff0000u); b[2] = __uint_as_float(gw.w << 16); b[3] = __uint_as_float(gw.w & 0xffff0000u);
    }
    __device__ __forceinline__ void mid(af4 (&acc)[2][2][4][2], const pg8::Unit& u, int t, int wr, int wc, int fr, int fq) const {
        const bf16_t* G = (const bf16_t*)(ws + WS_GT) + (t == 8 ? 0 : 1024);
        int rbase = u.pm * 256 + wr * 64 + fr; const int col0 = u.pn * 256 + wc * 32 + 8 * fq;
        asm volatile("" : "+v"(rbase));
#pragma unroll
        for (int ai = 0; ai < 2; ++ai)
#pragma unroll
            for (int m = 0; m < 4; ++m) { const int r = rbase + ai * 128 + m * 16;
#pragma unroll
                for (int bj = 0; bj < 2; ++bj) { const bf16_t* gp = G + (unsigned)(r * 3072 + col0 + bj * 128); af4 na, nb, da, db; unpack8(*(const u32x4*)gp, na, nb); unpack8(*(const u32x4*)(gp + 1024), da, db);
#pragma unroll
                    for (int i = 0; i < 4; ++i) { acc[ai][bj][m][0][i] *= na[i] * __builtin_amdgcn_rcpf(da[i]); acc[ai][bj][m][1][i] *= nb[i] * __builtin_amdgcn_rcpf(db[i]); } }
                if ((m & HOOKF) == HOOKF) asm volatile("" ::: "memory"); }
    }
    __device__ __forceinline__ void operator()(EPI_ARGS) const {
        const bf16_t* G = (const bf16_t*)(ws + WS_GT) + 2048; bf16_t* H = (bf16_t*)(ws + WS_H);
        const int rbase = u.pm * 256 + wr * 64 + fr; const int col0 = u.pn * 256 + wc * 32 + 8 * fq;
#pragma unroll
        for (int ai = 0; ai < 2; ++ai) {
            u32x4 gv[4][2];
#pragma unroll
            for (int m = 0; m < 4; ++m)
#pragma unroll
                for (int bj = 0; bj < 2; ++bj) gv[m][bj] = *(const u32x4*)(G + (unsigned)((rbase + ai * 128 + m * 16) * 3072 + col0 + bj * 128));
#pragma unroll
            for (int m = 0; m < 4; ++m) { const int r = rbase + ai * 128 + m * 16;
#pragma unroll
                for (int bj = 0; bj < 2; ++bj) { const int c = col0 + bj * 128; af4 ga, gb; unpack8(gv[m][bj], ga, gb);
                    const af4 a = acc[ai][bj][m][0] * ga, b = acc[ai][bj][m][1] * gb;
                    u32x4 w; w.x = pk2(a[0], a[1]); w.y = pk2(a[2], a[3]); w.z = pk2(b[0], b[1]); w.w = pk2(b[2], b[3]); *(u32x4*)(H + (size_t)r * 1024 + c) = w; } }
            asm volatile("" ::: "memory");
        }
    }
};

struct EpiWo {
    static constexpr bool PERM = true, AFTER_DRAIN = false, MID = false;
    const float* xp; const float* xs; float* out; bf16_t* X1B; float* ssq;
    __device__ __forceinline__ void operator()(EPI_ARGS) const {
        const int rbase = u.pm * 256 + wr * 64 + fr; const int col0 = u.pn * 256 + wc * 32 + 8 * fq;
        const float *xA = opq(xs), *xB = opq(xp);
        const float* xin = u.pm >= 64 ? xA - (size_t)MP * 1024 : xB;
#pragma unroll
        for (int ai = 0; ai < 2; ++ai) {
            af4 xv[4][2][2];
#pragma unroll
            for (int m = 0; m < 4; ++m)
#pragma unroll
                for (int bj = 0; bj < 2; ++bj) { const size_t o = (size_t)(rbase + ai * 128 + m * 16) * 1024 + col0 + bj * 128; xv[m][bj][0] = *(const af4*)(xin + o); xv[m][bj][1] = *(const af4*)(xin + o + 4); }
#pragma unroll
            for (int m = 0; m < 4; ++m) { const int r = rbase + ai * 128 + m * 16; float ss = 0.f;
#pragma unroll
                for (int bj = 0; bj < 2; ++bj) { const size_t o = (size_t)r * 1024 + col0 + bj * 128;
                    const af4 a = acc[ai][bj][m][0] + xv[m][bj][0], b = acc[ai][bj][m][1] + xv[m][bj][1];
                    ss += (a[0] * a[0] + a[1] * a[1]) + (a[2] * a[2] + a[3] * a[3]) + (b[0] * b[0] + b[1] * b[1]) + (b[2] * b[2] + b[3] * b[3]);
                    u32x4 w; w.x = pk2(a[0], a[1]); w.y = pk2(a[2], a[3]); w.z = pk2(b[0], b[1]); w.w = pk2(b[2], b[3]); *(u32x4*)(X1B + o) = w; }
                ss += __shfl_xor(ss, 16); ss += __shfl_xor(ss, 32);
                if (fq == 0) unsafeAtomicAdd(ssq + r, ss); }
            asm volatile("" ::: "memory");
        }
    }
};

struct EpiUp {
    static constexpr bool PERM = true, AFTER_DRAIN = false, MID = false;
    unsigned char* ws;
    __device__ __forceinline__ void operator()(EPI_ARGS) const {
        bf16_t* HF = (bf16_t*)(ws + WS_HF); const float* ssq = (const float*)(ws + WS_SSQ2);
        const int rbase = u.pm * 256 + wr * 64 + fr; const int col0 = u.pn * 256 + wc * 32 + 8 * fq;
        float sq[2][4];
#pragma unroll
        for (int ai = 0; ai < 2; ++ai)
#pragma unroll
            for (int m = 0; m < 4; ++m) sq[ai][m] = ssq[rbase + ai * 128 + m * 16];
#pragma unroll
        for (int ai = 0; ai < 2; ++ai)
#pragma unroll
            for (int m = 0; m < 4; ++m) { const int r = rbase + ai * 128 + m * 16; const float rs = 1.0f / sqrtf(sq[ai][m] * (1.0f / 1024.0f) + EPS);
#pragma unroll
                for (int bj = 0; bj < 2; ++bj) { af4 a = acc[ai][bj][m][0] * rs, b = acc[ai][bj][m][1] * rs;
#pragma unroll
                    for (int i = 0; i < 4; ++i) { a[i] = fmaxf(a[i], 0.f); a[i] *= a[i]; b[i] = fmaxf(b[i], 0.f); b[i] *= b[i]; }
                    u32x4 w; w.x = pk2(a[0], a[1]); w.y = pk2(a[2], a[3]); w.z = pk2(b[0], b[1]); w.w = pk2(b[2], b[3]);
                    *(u32x4*)(HF + (size_t)r * 4096 + col0 + bj * 128) = w; } }
    }
};

struct EpiDown {
    static constexpr bool PERM = true, AFTER_DRAIN = false, MID = false;
    float* out; const bf16_t* X1B;
    __device__ __forceinline__ void operator()(EPI_ARGS) const {
        const int rbase = u.pm * 256 + wr * 64 + fr; const int col0 = u.pn * 256 + wc * 32 + 8 * fq;
#pragma unroll
        for (int ai = 0; ai < 2; ++ai) {
            u32x4 xv[4][2];
#pragma unroll
            for (int m = 0; m < 4; ++m)
#pragma unroll
                for (int bj = 0; bj < 2; ++bj) xv[m][bj] = *(const u32x4*)(X1B + (size_t)(rbase + ai * 128 + m * 16) * 1024 + col0 + bj * 128);
#pragma unroll
            for (int m = 0; m < 4; ++m) { const int r = rbase + ai * 128 + m * 16;
#pragma unroll
                for (int bj = 0; bj < 2; ++bj) { float* p = out + (size_t)r * 1024 + col0 + bj * 128; af4 xa, xb; EpiMergeH::unpack8raw(xv[m][bj], xa, xb);
                    const af4 a = acc[ai][bj][m][0] + xa, b = acc[ai][bj][m][1] + xb; *(af4*)p = a; *(af4*)(p + 4) = b; } }
            asm volatile("" ::: "memory");
        }
    }
};

enum { A_BANDP = 0, A_FORGETP = 1, A_MEMP = 2, A_BANDS = 3, A_FORGETS = 4, A_MEMS = 5 };
#define LDS_BAR() do { asm volatile("s_waitcnt lgkmcnt(0)" ::: "memory"); __builtin_amdgcn_s_barrier(); asm volatile("" ::: "memory"); } while (0)
#define MFMA32(a, b, c) __builtin_amdgcn_mfma_f32_32x32x16_bf16((a), (b), (c), 0, 0, 0)
typedef short v4i16_t __attribute__((ext_vector_type(4)));
__device__ __forceinline__ s16x4 tr_read(const LAS char* p) { return __builtin_bit_cast(s16x4, __builtin_amdgcn_ds_read_tr16_b64_v4i16((LAS v4i16_t*)p)); }
constexpr int ATT_TB_OFF = 96 * 1024, ATT_ITEM_OFF = ATT_TB_OFF + 2048;
constexpr float NEGBIG = -1e30f;

struct AttnCtx {
    const float* const* in;
    float* out; unsigned char* ws;
};
template <int D> struct TileRegs { u32x4 k[2]; u32x4 v[2]; float kb; };
template <int D, int MODE> struct PKof { static constexpr int PK = D * 2 + 16 + ((MODE == A_FORGETP || MODE == A_FORGETS) ? 32 : 0); };
#ifndef FP_KT
#define FP_KT 128
#endif
template <int D, int MODE> struct KTof { static constexpr int KT = D == 128 ? 32 : (MODE == A_FORGETP ? FP_KT : 64), TPR = 512 / KT, CPT = D * KT / 512; };
template <int MODE> __device__ __forceinline__ bool tile_is_f32(int j) {
    return MODE == A_MEMS || (MODE == A_BANDS && j < 8) || (MODE == A_FORGETS && j < 32);
}
__device__ __forceinline__ u32x4 ld16(const void* p) { return *(const u32x4*)p; }

template <int D, int MODE> __device__ __forceinline__ void tile_issue(TileRegs<D>& T, const Args& A, const unsigned char* ws, int j, int b, int h, int tid) {
    constexpr int KT = KTof<D, MODE>::KT, TPR = KTof<D, MODE>::TPR, CPT = KTof<D, MODE>::CPT;
    const int row = tid / TPR, cgp = tid % TPR;
    const int hcol = h * D + cgp * CPT;
    const u32x4 z = {0u, 0u, 0u, 0u};
#pragma unroll
    for (int i = 0; i < 2; ++i) { T.k[i] = z; T.v[i] = z; }
    T.kb = 0.f;
    if (MODE == A_BANDP || MODE == A_FORGETP) {
        const size_t o = (size_t)(b * SEQ + KT * j + row) * 512 + hcol;
        const bf16_t* kp = (const bf16_t*)(ws + (MODE == A_BANDP ? WS_KA : WS_KB)) + o; const bf16_t* vp = (const bf16_t*)(ws + (MODE == A_BANDP ? WS_VA : WS_VB)) + o;
#pragma unroll
        for (int i = 0; i < CPT / 8; ++i) { T.k[i] = ld16(kp + 8 * i); T.v[i] = ld16(vp + 8 * i); }
        if (MODE == A_FORGETP && cgp == 0) T.kb = ((const float*)(ws + WS_CP))[(size_t)(b * 8 + h) * SEQ + KT * j + row];
    } else if (MODE == A_MEMP) {
        const size_t o = (size_t)(b * NMEM + KT * j + row) * 512 + hcol;
        const float* kp = (const float*)(ws + WS_MKRAW) + o; const bf16_t* vp = (const bf16_t*)(ws + WS_MVB) + o;
#pragma unroll
        for (int i = 0; i < 2; ++i) T.k[i] = ld16(kp + 4 * i);
        T.v[0] = ld16(vp);
        const float* pk = (const float*)(ws + WS_PARTK) + (size_t)(b * NMEM + KT * j + row) * 8 + h * 2;
        T.kb = 1.0f / sqrtf((pk[0] + pk[1]) * (1.0f / 128.0f) + EPS);
    } else if (tile_is_f32<MODE>(j)) {
        const float *ksrc, *vsrc; size_t o;
        if (MODE == A_BANDS) { ksrc = A.in[3]; vsrc = A.in[4]; o = (size_t)(b * ACACHE + KT * j + row) * 512 + hcol; }
        else if (MODE == A_FORGETS) { ksrc = A.in[5]; vsrc = A.in[6]; o = (size_t)(b * PAST + KT * j + row) * 512 + hcol; }
        else { ksrc = A.in[8]; vsrc = A.in[9]; o = (size_t)(b * NMEM + KT * j + row) * 512 + hcol; }
#pragma unroll
        for (int i = 0; i < 2; ++i) { T.k[i] = ld16(ksrc + o + 4 * i); T.v[i] = ld16(vsrc + o + 4 * i); }
        if (MODE == A_FORGETS && cgp == 0) T.kb = ((const float*)(ws + WS_CS))[(size_t)(b * 8 + h) * SLEN + KT * j + row];
    } else {
        if (row < SSEQ) {
            const size_t o = (size_t)(MP + b * SSEQ + row) * 512 + hcol;
            const bf16_t* kp = (const bf16_t*)(ws + (MODE == A_BANDS ? WS_KA : WS_KB)) + o; const bf16_t* vp = (const bf16_t*)(ws + (MODE == A_BANDS ? WS_VA : WS_VB)) + o;
            T.k[0] = ld16(kp); T.v[0] = ld16(vp);
            if (MODE == A_FORGETS && cgp == 0) T.kb = ((const float*)(ws + WS_CS))[(size_t)(b * 8 + h) * SLEN + PAST + row];
        }
    }
}
__device__ __forceinline__ u32x4 cvt8(const u32x4 a, const u32x4 b) {
    u32x4 w; w.x = pk2(__uint_as_float(a.x), __uint_as_float(a.y)); w.y = pk2(__uint_as_float(a.z), __uint_as_float(a.w));
    w.z = pk2(__uint_as_float(b.x), __uint_as_float(b.y)); w.w = pk2(__uint_as_float(b.z), __uint_as_float(b.w)); return w;
}
template <int D, int MODE> __device__ __forceinline__ void tile_store(TileRegs<D>& T, LAS char* buf, const Args& A, float* out, int j, int b, int h, int tid, float cref, bool emit) {
    constexpr int PK = PKof<D, MODE>::PK, KT = KTof<D, MODE>::KT, TPR = KTof<D, MODE>::TPR, CPT = KTof<D, MODE>::CPT;
    const int row = tid / TPR, cgp = tid % TPR;
    LAS char* kd = buf + row * PK + cgp * CPT * 2; LAS char* vd = buf + KT * PK + row * (D * 2 + 16) + cgp * CPT * 2;
    if (MODE == A_MEMP) {
        const float* g = A.in[18] + cgp * 8; const float rk = T.kb;
#pragma unroll
        for (int i = 0; i < 2; ++i) { const f32x4 gv = *(const f32x4*)(g + 4 * i); f32x4 x = __builtin_bit_cast(f32x4, T.k[i]); x = x * rk * gv; T.k[i] = __builtin_bit_cast(u32x4, x); }
        if (emit) { float* o = out + O_MKP + (size_t)(b * NMEM + KT * j + row) * 512 + h * D + cgp * 8;
#pragma unroll
            for (int i = 0; i < 2; ++i) *(u32x4*)(o + 4 * i) = T.k[i]; }
        { *(LAS u32x4*)kd = cvt8(T.k[0], T.k[1]); *(LAS u32x4*)vd = T.v[0]; }
    } else if (tile_is_f32<MODE>(j)) {
        { *(LAS u32x4*)kd = cvt8(T.k[0], T.k[1]); *(LAS u32x4*)vd = cvt8(T.v[0], T.v[1]); }
    } else {
        {
#pragma unroll
            for (int i = 0; i < CPT / 8; ++i) { *(LAS u32x4*)(kd + 16 * i) = T.k[i]; *(LAS u32x4*)(vd + 16 * i) = T.v[i]; } }
    }
    if ((MODE == A_FORGETP || MODE == A_FORGETS) && cgp == 0) {
        const float kb = cref - T.kb; const unsigned h0 = f2bf(kb); const float r1 = kb - __uint_as_float(h0 << 16); const unsigned h1 = f2bf(r1); const float r2 = r1 - __uint_as_float(h1 << 16); const unsigned h2 = f2bf(r2);
        const u32x4 w0 = {h0 | (h1 << 16), h2, 0u, 0u}, w1 = {0u, 0u, 0u, 0u};
        *(LAS u32x4*)(buf + row * PK + D * 2) = w0; *(LAS u32x4*)(buf + row * PK + D * 2 + 16) = w1; }
}

template <int D, int NH, int PK>
__device__ __forceinline__ void softmax_pv(f32x16 (&p)[NH], const LAS char* Vl, f32x16 (&O)[D / 32 + 1], float& m_run, float& l_run, bool first, int lane) {
    const int hh = lane >> 5;
    float mt = p[0][0];
#pragma unroll
    for (int i = 1; i < 16; ++i) mt = fmaxf(mt, p[0][i]);
#pragma unroll
    for (int half = 1; half < NH; ++half)
#pragma unroll
        for (int i = 0; i < 16; ++i) mt = fmaxf(mt, p[half][i]);
    mt = fmaxf(mt, __shfl_xor(mt, 32));
    if (first || __any(mt > 0.f)) {
        const float dl = first ? mt : fmaxf(mt, 0.f); const float alpha = first ? 0.f : __builtin_amdgcn_exp2f(-dl);
        m_run += dl;
#pragma unroll
        for (int half = 0; half < NH; ++half) p[half] = p[half] - dl;
#pragma unroll
        for (int d = 0; d <= D / 32; ++d) O[d] = O[d] * alpha;
    }
#pragma unroll
    for (int half = 0; half < NH; ++half)
#pragma unroll
        for (int i = 0; i < 16; ++i) p[half][i] = __builtin_amdgcn_exp2f(p[half][i]);
    bf16x8 vones;
#pragma unroll
    for (int j = 0; j < 8; ++j) vones[j] = (lane & 31) == 0 ? (short)0x3F80 : (short)0;
    const int q4 = (lane & 15) >> 2, p3 = lane & 3, blk = (lane >> 4) & 1;
#pragma unroll
    for (int half = 0; half < NH; ++half)
#pragma unroll
        for (int s2 = 0; s2 < 2; ++s2) {
            u32x4 pw; pw.x = pk2(p[half][8 * s2], p[half][8 * s2 + 1]); pw.y = pk2(p[half][8 * s2 + 2], p[half][8 * s2 + 3]);
            pw.z = pk2(p[half][8 * s2 + 4], p[half][8 * s2 + 5]); pw.w = pk2(p[half][8 * s2 + 6], p[half][8 * s2 + 7]);
            const bf16x8 pf = __builtin_bit_cast(bf16x8, pw);
#pragma unroll
            for (int d = 0; d < D / 32; ++d) {
                const LAS char* vp = Vl + (32 * half + 16 * s2 + 4 * hh + q4) * PK + d * 64 + blk * 32 + p3 * 8;
                const s16x4 lo = tr_read(vp), hi = tr_read(vp + 8 * PK);
                const bf16x8 vf = __builtin_shufflevector(lo, hi, 0, 1, 2, 3, 4, 5, 6, 7);
                O[d] = MFMA32(vf, pf, O[d]);
            }
            O[D / 32] = MFMA32(vones, pf, O[D / 32]);
        }
}

template <int D, int MODE>
__device__ __forceinline__ void compute_tile(const LAS char* buf, const bf16x8 (&qf)[D / 16], f32x16 (&O)[D / 32 + 1], float& m_run, float& l_run, bool first,
                                             int lane, int qpos, int qpos_min, int kpos0, bool diag, int nvalid, const LAS float* tb, float rq) {
    constexpr int PK = PKof<D, MODE>::PK, KT = KTof<D, MODE>::KT, NH = KT / 32;
    const int r = lane & 31, hh = lane >> 5;
    const LAS char* Kl = buf; const LAS char* Vl = buf + KT * PK;
    f32x16 p[NH];
    constexpr bool BAND = (MODE == A_BANDP || MODE == A_BANDS), FORGET = (MODE == A_FORGETP || MODE == A_FORGETS), MEM = (MODE == A_MEMP || MODE == A_MEMS);
    const bool far = BAND && (qpos_min - (kpos0 + KT - 1) >= 128);
    const float c0 = MEM ? 0.f : (far ? tb[256] : 0.f) - m_run;
#pragma unroll
    for (int half = 0; half < NH; ++half)
#pragma unroll
        for (int i = 0; i < 16; ++i) p[half][i] = c0;
    if (FORGET) {
        bf16x8 qone;
#pragma unroll
        for (int j = 0; j < 8; ++j) qone[j] = (hh == 0 && j < 3) ? (short)0x3F80 : (short)0;
#pragma unroll
        for (int half = 0; half < NH; ++half) { const bf16x8 kf = *(const LAS bf16x8*)(Kl + (32 * half + r) * PK + D * 2 + 16 * hh); p[half] = MFMA32(kf, qone, p[half]); }
    }
#pragma unroll
    for (int half = 0; half < NH; ++half)
#pragma unroll
        for (int s = 0; s < D / 16; ++s) { const bf16x8 kf = *(const LAS bf16x8*)(Kl + (32 * half + r) * PK + (16 * s + 8 * hh) * 2); p[half] = MFMA32(kf, qf[s], p[half]); }
    if (MEM) {
#pragma unroll
        for (int half = 0; half < NH; ++half) p[half] = p[half] * rq - m_run;
    }
    if (BAND && !far) {
#pragma unroll
        for (int half = 0; half < NH; ++half)
#pragma unroll
            for (int i = 0; i < 16; ++i) { const int kv = kpos0 + 32 * half + (i & 3) + 8 * (i >> 2) + 4 * hh; int dist = qpos - kv; dist = dist < -128 ? -128 : dist; dist = dist > 128 ? 128 : dist; p[half][i] += tb[dist + 128]; }
    }
    if (FORGET && diag) {
#pragma unroll
        for (int half = 0; half < NH; ++half)
#pragma unroll
            for (int i = 0; i < 16; ++i) { const int kv = kpos0 + 32 * half + (i & 3) + 8 * (i >> 2) + 4 * hh; if (kv > qpos) p[half][i] = NEGBIG; }
    }
    if (MODE == A_BANDS && nvalid < KT) {
#pragma unroll
        for (int half = 0; half < NH; ++half)
#pragma unroll
            for (int i = 0; i < 16; ++i) { const int kl = 32 * half + (i & 3) + 8 * (i >> 2) + 4 * hh; if (kl >= nvalid) p[half][i] = NEGBIG; }
    }
    softmax_pv<D, NH, D * 2 + 16>(p, Vl, O, m_run, l_run, first, lane);
}

template <int D, int MODE>
__device__ __forceinline__ void attn_unit(const Args& A, float* out, unsigned char* ws, LAS char* lds, int b, int h, int qb) {
    constexpr int PK = PKof<D, MODE>::PK, KT = KTof<D, MODE>::KT, BUFSZ = KT * PK + KT * (D * 2 + 16) + 256;
    constexpr bool BAND = (MODE == A_BANDP || MODE == A_BANDS), FORGET = (MODE == A_FORGETP || MODE == A_FORGETS), MEM = (MODE == A_MEMP || MODE == A_MEMS);
    constexpr bool SAMPLE = (MODE >= A_BANDS);
    static_assert(2 * BUFSZ <= ATT_TB_OFF, "attention LDS");
    const int tid = threadIdx.x, lane = tid & 63, r = lane & 31, hh = lane >> 5; const int wid = __builtin_amdgcn_readfirstlane(tid >> 6);
    LAS float* tb = (LAS float*)(lds + ATT_TB_OFF);
    int j0 = 0, j1 = 0, qpos = 0, qpos_min = 0, qrow = 0, jlo = 0, jhi = 0;
    if (MODE == A_BANDP) { const int c = 4 * qb + (wid >> 1); qpos_min = c * 64 + (wid & 1) * 32; qpos = qpos_min + r; qrow = b * SEQ + qpos; j0 = 4 * qb - 8 < 0 ? 0 : 4 * qb - 8; j1 = 4 * qb + 3; jlo = c - 8; jhi = c; }
    else if (MODE == A_FORGETP) { qpos_min = qb * 256 + 32 * wid; qpos = qpos_min + r; qrow = b * SEQ + qpos; j0 = 0; j1 = (qb * 256 + 255) / KT; jlo = 0; jhi = qpos_min / KT; }
    else if (MODE == A_MEMP) { qrow = b * SEQ + qb * 256 + 32 * wid + r; j0 = 0; j1 = NMEM / KT - 1; jlo = 0; jhi = j1; }
    else { qpos_min = PAST; qpos = PAST + (r & 15); qrow = MP + b * SSEQ + (r & 15); j0 = 0; j1 = MODE == A_BANDS ? 8 : MODE == A_FORGETS ? 32 : NMEM / KT - 1; jlo = 0; jhi = wid == 0 ? j1 : -1; }
    if (BAND && tid < 257) tb[tid] = A.in[19][tid * 8 + h] * LOG2E;
    const bf16_t* Qb = (const bf16_t*)(ws + (BAND ? WS_QA : FORGET ? WS_QB : WS_QM));
    bf16x8 qf[D / 16];
#pragma unroll
    for (int s = 0; s < D / 16; ++s) qf[s] = *(const bf16x8*)(Qb + (size_t)qrow * 512 + h * D + 16 * s + 8 * hh);
    float rq = 1.f;
    if (MEM) { const float* pq = (const float*)(ws + WS_PARTQ) + (size_t)qrow * 8 + h * 2; rq = 1.0f / sqrtf((pq[0] + pq[1]) * (1.0f / 128.0f) + EPS); }
    float cref = 0.f;
    if (MODE == A_FORGETP) cref = ((const float*)(ws + WS_CP))[(size_t)(b * 8 + h) * SEQ + qb * 256];
    if (MODE == A_FORGETS) cref = ((const float*)(ws + WS_CS))[(size_t)(b * 8 + h) * SLEN + PAST];
    f32x16 O[D / 32 + 1];
#pragma unroll
    for (int d = 0; d <= D / 32; ++d)
#pragma unroll
        for (int i = 0; i < 16; ++i) O[d][i] = 0.f;
    float m_run = 0.f, l_run = 0.f; bool first = true;
    TileRegs<D> T;
    const int jstart = FORGET ? j1 : j0, jend = FORGET ? j0 : j1, jstep = FORGET ? -1 : 1;
    tile_issue<D, MODE>(T, A, ws, jstart, b, h, tid);
    for (int j = jstart, n = 0;; j += jstep, ++n) {
        LAS char* buf = lds + (n & 1) * BUFSZ;
        tile_store<D, MODE>(T, buf, A, out, j, b, h, tid, cref, qb == 0);
        if (j != jend) tile_issue<D, MODE>(T, A, ws, j + jstep, b, h, tid);
        LDS_BAR();
        if (j >= jlo && j <= jhi) {
            int kpos0 = KT * j, nvalid = KT; bool diag = false;
            if (MODE == A_BANDS) { kpos0 = PAST - ACACHE + 64 * j; if (j == 8) nvalid = SSEQ; }
            if (MODE == A_FORGETP) diag = (j == jhi);
            if (MODE == A_FORGETS) diag = (j == 32);
            compute_tile<D, MODE>(buf, qf, O, m_run, l_run, first, lane, qpos, qpos_min, kpos0, diag, nvalid, tb, rq);
            first = false;
        }
        if (j == jend) break;
    }
    const float l = __shfl(O[D / 32][0], lane & 31); const float inv = 1.0f / l;
    bf16_t* Ob = (bf16_t*)(ws + WS_OC) + (size_t)qrow * 1536 + (BAND ? 0 : FORGET ? 512 : 1024) + h * D;
    if (!SAMPLE || (wid == 0 && r < SSEQ)) {
#pragma unroll
        for (int d = 0; d < D / 32; ++d)
#pragma unroll
            for (int i4 = 0; i4 < 4; ++i4) { u32x2 w; w.x = pk2(O[d][4 * i4] * inv, O[d][4 * i4 + 1] * inv); w.y = pk2(O[d][4 * i4 + 2] * inv, O[d][4 * i4 + 3] * inv);
                *(u32x2*)(Ob + d * 32 + 8 * i4 + 4 * hh) = w; }
    }
    LDS_BAR();
}


__device__ __forceinline__ bf16x8 cvt8f(const f32x4 a, const f32x4 b) { u32x4 w; w.x = pk2(a[0], a[1]); w.y = pk2(a[2], a[3]); w.z = pk2(b[0], b[1]); w.w = pk2(b[2], b[3]); return __builtin_bit_cast(bf16x8, w); }
template <int D> struct STile { f32x4 k[D / 8]; f32x4 v[D / 8]; float cs; };
template <int D, int MODE> __device__ __forceinline__ void stile_load(STile<D>& S, const float* kc, const float* vc, const float* csp, int t, int lane) {
    const int r = lane & 31, hh = lane >> 5;
    const float* kp = kc + (size_t)(32 * t + r) * 512 + 8 * hh;
#pragma unroll
    for (int s = 0; s < D / 16; ++s) { S.k[2 * s] = *(const f32x4*)(kp + 16 * s); S.k[2 * s + 1] = *(const f32x4*)(kp + 16 * s + 4); }
    const float* vp = vc + (size_t)(32 * t + (lane >> 1)) * 512 + (lane & 1) * (D / 2);
#pragma unroll
    for (int i = 0; i < D / 8; ++i) S.v[i] = *(const f32x4*)(vp + 4 * i);
    S.cs = (MODE == A_FORGETS) ? csp[32 * t + r] : 0.f;
}
template <int D, int MODE>
__device__ __forceinline__ void stile_compute(const bf16x8 (&kf)[D / 16], float kbias, LAS char* Vw, const bf16x8 (&qf)[D / 16], f32x16 (&O)[D / 32 + 1], float& m_run, float& l_run, bool first,
                                              int lane, int qpos, int kpos0, bool lastnew, const LAS float* tb, float rq) {
    constexpr int PV = D * 2 + 16;
    constexpr bool BAND = (MODE == A_BANDS), FORGET = (MODE == A_FORGETS), MEM = (MODE == A_MEMS);
    const int hh = lane >> 5;
    const bool far = BAND && (PAST - (kpos0 + 31) >= 128);
    f32x16 p[1];
    const float c0 = MEM ? 0.f : (far ? tb[256] : 0.f) - m_run;
#pragma unroll
    for (int i = 0; i < 16; ++i) p[0][i] = c0;
    if (FORGET) {
        const unsigned h0 = f2bf(kbias); const float r1 = kbias - __uint_as_float(h0 << 16); const unsigned h1 = f2bf(r1); const float r2 = r1 - __uint_as_float(h1 << 16); const unsigned h2 = f2bf(r2);
        u32x4 kw = {h0 | (h1 << 16), h2, 0u, 0u}; if (hh) kw = (u32x4){0u, 0u, 0u, 0u};
        bf16x8 qone;
#pragma unroll
        for (int j = 0; j < 8; ++j) qone[j] = (hh == 0 && j < 3) ? (short)0x3F80 : (short)0;
        p[0] = MFMA32(__builtin_bit_cast(bf16x8, kw), qone, p[0]);
    }
#pragma unroll
    for (int s = 0; s < D / 16; ++s) p[0] = MFMA32(kf[s], qf[s], p[0]);
    if (MEM) p[0] = p[0] * rq - m_run;
    if (BAND && !far) {
#pragma unroll
        for (int i = 0; i < 16; ++i) { const int kl = (i & 3) + 8 * (i >> 2) + 4 * hh; int dist = qpos - (kpos0 + kl); dist = dist < -128 ? -128 : dist; dist = dist > 128 ? 128 : dist; p[0][i] += tb[dist + 128]; if (lastnew && kl >= SSEQ) p[0][i] = NEGBIG; }
    }
    if (FORGET && lastnew) {
#pragma unroll
        for (int i = 0; i < 16; ++i) { const int kl = (i & 3) + 8 * (i >> 2) + 4 * hh; if (kpos0 + kl > qpos) p[0][i] = NEGBIG; }
    }
    softmax_pv<D, 1, PV>(p, Vw, O, m_run, l_run, first, lane);
}
template <int D, int MODE>
__device__ __forceinline__ void attn_unit_sample(const Args& A, unsigned char* ws, LAS char* lds, int b, int h) {
    constexpr int PV = D * 2 + 16;
    constexpr bool BAND = (MODE == A_BANDS), FORGET = (MODE == A_FORGETS), MEM = (MODE == A_MEMS);
    static_assert(8 * 32 * PV <= ATT_TB_OFF && (256 + 8 * D * 16) * 4 <= ATT_TB_OFF, "sample attention LDS");
    const int tid = threadIdx.x, lane = tid & 63, r = lane & 31, hh = lane >> 5; const int wid = __builtin_amdgcn_readfirstlane(tid >> 6);
    LAS char* Vw = lds + wid * (32 * PV);
    LAS float* tb = (LAS float*)(lds + ATT_TB_OFF);
    constexpr int NCACHE = BAND ? ACACHE : FORGET ? PAST : NMEM, NTC = NCACHE / 32;
    const float* kc = (BAND ? A.in[3] : FORGET ? A.in[5] : A.in[8]) + (size_t)b * NCACHE * 512 + h * D;
    const float* vc = (BAND ? A.in[4] : FORGET ? A.in[6] : A.in[9]) + (size_t)b * NCACHE * 512 + h * D;
    const float* csp = (const float*)(ws + WS_CS) + (size_t)(b * 8 + h) * SLEN;
    const int qrow = MP + b * SSEQ + (r & 15), qpos = PAST + (r & 15);
    if (BAND) { if (tid < 257) tb[tid] = A.in[19][tid * 8 + h] * LOG2E; LDS_BAR(); }
    const bf16_t* Qb = (const bf16_t*)(ws + (BAND ? WS_QA : FORGET ? WS_QB : WS_QM));
    bf16x8 qf[D / 16];
#pragma unroll
    for (int s = 0; s < D / 16; ++s) qf[s] = *(const bf16x8*)(Qb + (size_t)qrow * 512 + h * D + 16 * s + 8 * hh);
    float rq = 1.f;
    if (MEM) { const float* pq = (const float*)(ws + WS_PARTQ) + (size_t)qrow * 8 + h * 2; rq = 1.0f / sqrtf((pq[0] + pq[1]) * (1.0f / 128.0f) + EPS); }
    const float cref = FORGET ? csp[PAST] : 0.f;
    f32x16 O[D / 32 + 1];
#pragma unroll
    for (int d = 0; d <= D / 32; ++d)
#pragma unroll
        for (int i = 0; i < 16; ++i) O[d][i] = 0.f;
    float m_run = 0.f, l_run = 0.f; bool first = true;
    const int kbase = BAND ? PAST - ACACHE : 0;
    STile<D> S;
    stile_load<D, MODE>(S, kc, vc, csp, wid, lane);
    for (int t = wid; t < NTC; t += 8) {
        bf16x8 kf[D / 16];
#pragma unroll
        for (int s = 0; s < D / 16; ++s) kf[s] = cvt8f(S.k[2 * s], S.k[2 * s + 1]);
        { LAS char* vd = Vw + (lane >> 1) * PV + (lane & 1) * D;
#pragma unroll
          for (int i = 0; i < D / 16; ++i) *(LAS bf16x8*)(vd + 16 * i) = cvt8f(S.v[2 * i], S.v[2 * i + 1]); }
        const float kb = cref - S.cs;
        if (D == 64 && t + 8 < NTC) stile_load<D, MODE>(S, kc, vc, csp, t + 8, lane);
        asm volatile("s_waitcnt lgkmcnt(0)" ::: "memory");
        stile_compute<D, MODE>(kf, kb, Vw, qf, O, m_run, l_run, first, lane, qpos, kbase + 32 * t, false, tb, rq);
        first = false;
        asm volatile("s_waitcnt lgkmcnt(0)" ::: "memory");
    }
    if (!MEM && wid == 0) {
        const bf16_t* kn = (const bf16_t*)(ws + (BAND ? WS_KA : WS_KB)) + (size_t)(MP + b * SSEQ) * 512 + h * D;
        const bf16_t* vn = (const bf16_t*)(ws + (BAND ? WS_VA : WS_VB)) + (size_t)(MP + b * SSEQ) * 512 + h * D;
        bf16x8 kf[D / 16]; const bf16x8 z8 = {0, 0, 0, 0, 0, 0, 0, 0};
#pragma unroll
        for (int s = 0; s < D / 16; ++s) kf[s] = r < SSEQ ? *(const bf16x8*)(kn + (size_t)r * 512 + 16 * s + 8 * hh) : z8;
        { const int row = lane >> 1; LAS char* vd = Vw + row * PV + (lane & 1) * D;
#pragma unroll
          for (int i = 0; i < D / 16; ++i) *(LAS bf16x8*)(vd + 16 * i) = row < SSEQ ? *(const bf16x8*)(vn + (size_t)row * 512 + (lane & 1) * (D / 2) + 8 * i) : z8; }
        const float kb = cref - ((FORGET && r < SSEQ) ? csp[PAST + r] : 0.f);
        asm volatile("s_waitcnt lgkmcnt(0)" ::: "memory");
        stile_compute<D, MODE>(kf, kb, Vw, qf, O, m_run, l_run, first, lane, qpos, PAST, true, tb, rq);
        asm volatile("s_waitcnt lgkmcnt(0)" ::: "memory");
    }
    const float l_tot = __shfl(O[D / 32][0], lane & 31);
    LDS_BAR();
    LAS float* Mw = (LAS float*)lds; LAS float* Lw = Mw + 128; LAS float* Ow = Mw + 256;
    if (r < SSEQ) {
        if (hh == 0) { Mw[wid * 16 + r] = m_run; Lw[wid * 16 + r] = l_tot; }
#pragma unroll
        for (int d = 0; d < D / 32; ++d)
#pragma unroll
            for (int i = 0; i < 16; ++i) Ow[(wid * D + d * 32 + (i & 3) + 8 * (i >> 2) + 4 * hh) * 16 + r] = O[d][i];
    }
    LDS_BAR();
    { const int q = tid & 15, dg = tid >> 4; float M = Mw[q];
#pragma unroll
      for (int w = 1; w < 8; ++w) M = fmaxf(M, Mw[w * 16 + q]);
      float sc[8], L = 0.f;
#pragma unroll
      for (int w = 0; w < 8; ++w) { sc[w] = __builtin_amdgcn_exp2f(Mw[w * 16 + q] - M); L += Lw[w * 16 + q] * sc[w]; }
      const float inv = 1.0f / L; float o[D / 32];
#pragma unroll
      for (int e = 0; e < D / 32; ++e) { const int d = dg * (D / 32) + e; float a = 0.f;
#pragma unroll
          for (int w = 0; w < 8; ++w) a += Ow[(w * D + d) * 16 + q] * sc[w];
          o[e] = a * inv; }
      bf16_t* Ob = (bf16_t*)(ws + WS_OC) + (size_t)(MP + b * SSEQ + q) * 1536 + (BAND ? 0 : FORGET ? 512 : 1024) + h * D + dg * (D / 32);
      if (D == 64) *(unsigned*)Ob = pk2(o[0], o[1]); else { u32x2 w2; w2.x = pk2(o[0], o[1]); w2.y = pk2(o[D / 32 - 2], o[D / 32 - 1]); *(u32x2*)Ob = w2; } }
    LDS_BAR();
}

constexpr int Q_FP = 512, Q_FS = Q_FP + 256, Q_BP = Q_FS + 512, Q_MP = Q_BP + 256, Q_BS = Q_MP + 256, Q_MS = Q_BS + 128;
__device__ __forceinline__ int queue_next(unsigned* ctr, LAS int* itemw) {
    if (threadIdx.x == 0) *itemw = (int)atomicAdd(ctr, 1u);
    LDS_BAR();
    const int it = __builtin_amdgcn_readfirstlane(*itemw);
    LDS_BAR();
    return it;
}
#ifndef ATTMASK
#define ATTMASK 63
#endif
#ifndef P2MASK
#define P2MASK 63
#endif
#define AM(k) (((ATTMASK >> (k)) & 1) && (pass == 0 || ((P2MASK >> (k)) & 1)))
__device__ __forceinline__ void attention_phase(const Args& A, float* out, unsigned char* ws, LAS char* lds, int pass) {
    unsigned* ctr = (unsigned*)(ws + WS_CTL) + pass;
    LAS int* itemw = (LAS int*)(lds + ATT_ITEM_OFF);
    int it = queue_next(ctr, itemw);
    while (it < 768) { const int g = it / 3, k = it % 3;
        if (k == 2) { if (AM(4)) attn_unit_sample<64, A_FORGETS>(A, ws, lds, g >> 3, g & 7); }
        else if (AM(1)) { const int idx = 2 * g + k; attn_unit<64, A_FORGETP>(A, out, ws, lds, (idx & 31) >> 3, idx & 7, 15 - (idx >> 5)); }
        it = queue_next(ctr, itemw); }
    while (it < 1536) { const int i = it - 768; const int g = i / 3, k = i % 3;
        if (k == 2) { if (AM(3)) attn_unit_sample<64, A_BANDS>(A, ws, lds, g >> 3, g & 7); }
        else if (AM(0)) { const int idx = 2 * g + k; attn_unit<64, A_BANDP>(A, out, ws, lds, (idx & 31) >> 3, idx & 7, idx >> 5); }
        it = queue_next(ctr, itemw); }
    while (it < 1920) { const int i = it - 1536; const int g = i / 3, k = i % 3;
        if (k == 2) { if (AM(5)) attn_unit_sample<128, A_MEMS>(A, ws, lds, g >> 2, g & 3); }
        else if (AM(2)) { const int idx = 2 * g + k; attn_unit<128, A_MEMP>(A, out, ws, lds, (idx & 15) >> 2, idx & 3, idx >> 4); }
        it = queue_next(ctr, itemw); }
}

__device__ __forceinline__ void transpose_item(const float* W, int ldw, int K, int src_col0, bf16_t* WT, int dst_row0, const float* g, LAS float* scr, int kb, int lane) {
    const int k0 = 64 * kb;
    float wv[32];
#pragma unroll
    for (int i = 0; i < 32; ++i) { const int kk = 2 * i + (lane >> 5); wv[i] = W[(size_t)(k0 + kk) * ldw + src_col0 + (lane & 31)]; }
    if (g) {
#pragma unroll
        for (int i = 0; i < 32; ++i) wv[i] *= g[k0 + 2 * i + (lane >> 5)];
    }
#pragma unroll
    for (int i = 0; i < 32; ++i) scr[(2 * i + (lane >> 5)) * 33 + (lane & 31)] = wv[i];
    asm volatile("s_waitcnt lgkmcnt(0)" ::: "memory");
    const int c = lane & 7;
#pragma unroll
    for (int j = 0; j < 4; ++j) { const int n = (lane >> 3) + 8 * j; const LAS float* s = scr + (8 * c) * 33 + n;
        u32x4 o; o.x = pk2(s[0 * 33], s[1 * 33]); o.y = pk2(s[2 * 33], s[3 * 33]); o.z = pk2(s[4 * 33], s[5 * 33]); o.w = pk2(s[6 * 33], s[7 * 33]);
        *(u32x4*)(WT + (size_t)(dst_row0 + n) * K + k0 + 8 * c) = o; }
    asm volatile("s_waitcnt lgkmcnt(0)" ::: "memory");
}
__device__ __forceinline__ int perm_src_blk(int wb) { const int bj = wb >> 2, wc = wb & 3; return 2 * wc + bj; }

__device__ __forceinline__ void prologue(const Args& A, float* out, unsigned char* ws, LAS char* lds) {
    const int tid = threadIdx.x, lane = tid & 63; const int wave = __builtin_amdgcn_readfirstlane(tid >> 6);
    const int gw = blockIdx.x * 8 + wave, NGW = gridDim.x * 8;
    const float *xpp = opq(A.in[0]), *xsp = opq(A.in[1]), *memp = opq(A.in[2]);
    if (blockIdx.x == 0 && tid < 64) ((unsigned*)(ws + WS_CTL))[tid] = 0u;
    { float* ssq = (float*)(ws + WS_SSQ2); for (int i = blockIdx.x * 512 + tid; i < MT; i += gridDim.x * 512) ssq[i] = 0.f; }
    LAS float* wfl = (LAS float*)(lds + 8 * 8448);
    for (int k = tid; k < 1024; k += 512) { const float* wp = A.in[11] + (size_t)k * DIN + 3072; const f32x4 a = *(const f32x4*)wp, b = *(const f32x4*)(wp + 4); const float g = A.in[10][k];
#pragma unroll
        for (int c = 0; c < 4; ++c) { wfl[c * 1024 + k] = a[c] * g; wfl[(c + 4) * 1024 + k] = b[c] * g; } }
    LAS float* scr = (LAS float*)(lds + wave * 8448);
    constexpr int I_IN = 208 * 16, I_MKV = 32 * 16;
    constexpr int NITEMS = I_IN + I_MKV;
    for (int it = gw; it < NITEMS; it += NGW) {
        int r = it;
        if (r < I_IN) { const int db = r >> 4, kb = r & 15, tile = db >> 3, wb = db & 7; int src;
            if (tile < 14) { const int sec = tile >> 1; const int secstart = sec < 6 ? sec * 512 : 3080; src = secstart + (tile & 1) * 256 + perm_src_blk(wb) * 32; }
            else src = 3592 + (tile - 14) * 256 + wb * 32;
            transpose_item(A.in[11], DIN, 1024, src, (bf16_t*)(ws + WS_WIN), db * 32, A.in[10], scr, kb, lane); continue; }
        r -= I_IN;
        { const int db = r >> 4, kb = r & 15, tile = db >> 3, wb = db & 7;
            transpose_item(A.in[21], 1024, 1024, tile * 256 + perm_src_blk(wb) * 32, (bf16_t*)(ws + WS_WMKV), db * 32, A.in[20], scr, kb, lane); }
    }
    LDS_BAR();
#define XROW_PTR(m_) ((m_) >= MT ? memp + (size_t)((m_) - MT) * 1024 : ((m_) < MP ? xpp + (size_t)(m_) * 1024 : xsp + (size_t)((m_) - MP) * 1024))
    f32x4 nx[4];
    if (gw < MT + 1024) { const f32x4* xr = (const f32x4*)XROW_PTR(gw) + lane;
#pragma unroll
        for (int j = 0; j < 4; ++j) nx[j] = xr[64 * j]; }
    for (int m = gw; m < MT + 1024; m += NGW) {
        const bool ismem = m >= MT;
        bf16_t* orow = ismem ? (bf16_t*)(ws + WS_MB) + (size_t)(m - MT) * 1024 : (bf16_t*)(ws + WS_XB) + (size_t)m * 1024;
        f32x4 v[4]; float ss = 0.f;
#pragma unroll
        for (int j = 0; j < 4; ++j) v[j] = nx[j];
        if (m + NGW < MT + 1024) { const f32x4* xr = (const f32x4*)XROW_PTR(m + NGW) + lane;
#pragma unroll
            for (int j = 0; j < 4; ++j) nx[j] = xr[64 * j]; }
#pragma unroll
        for (int j = 0; j < 4; ++j) ss += (v[j][0] * v[j][0] + v[j][1] * v[j][1]) + (v[j][2] * v[j][2] + v[j][3] * v[j][3]);
        const float rstd = 1.0f / sqrtf(wave_sum(ss) * (1.0f / 1024.0f) + EPS);
        u32x2* o8 = (u32x2*)orow + lane;
#pragma unroll
        for (int j = 0; j < 4; ++j) { u32x2 w; w.x = pk2(v[j][0], v[j][1]); w.y = pk2(v[j][2], v[j][3]); o8[64 * j] = w; }
        if (ismem) { if (lane == 0) ((float*)(ws + WS_RSTDM))[m - MT] = rstd; continue; }
        if (lane == 0) ((float*)(ws + WS_RSTD1))[m] = rstd;
        float d[8];
#pragma unroll
        for (int c = 0; c < 8; ++c) d[c] = 0.f;
#pragma unroll
        for (int j = 0; j < 4; ++j)
#pragma unroll
            for (int c = 0; c < 8; ++c) { const f32x4 w = *(const LAS f32x4*)(wfl + c * 1024 + 4 * (lane + 64 * j)); d[c] += (v[j][0] * w[0] + v[j][1] * w[1]) + (v[j][2] * w[2] + v[j][3] * w[3]); }
        float mine = 0.f;
#pragma unroll
        for (int c = 0; c < 8; ++c) { const float s = wave_sum(d[c]); if (lane == c) mine = s; }
        if (lane < 8) { const float z = mine * rstd + A.in[12][lane]; const float lf = fminf(z, 0.f) - log1pf(expf(-fabsf(z)));
            if (m < MP) out[O_LFP + (size_t)m * 8 + lane] = lf; else out[O_LFS + (size_t)(m - MP) * 8 + lane] = lf; }
    }
}


__device__ __forceinline__ void late_weights(const Args& A, unsigned char* ws, LAS char* lds, int gw, int NGW) {
    const int lane = threadIdx.x & 63; const int wave = __builtin_amdgcn_readfirstlane(threadIdx.x >> 6);
    LAS float* scr = (LAS float*)(lds + wave * 8448);
    const float *wpa = opq(A.in[22]), *wpb = opq(A.in[23]), *wpm = opq(A.in[24]);
    constexpr int I_P = 32 * 8, I_O = 32 * 16, I_UP = 128 * 16, I_DN = 32 * 64;
    constexpr int NITEMS = 3 * I_P + I_O + I_UP + I_DN;
    for (int it = gw; it < NITEMS; it += NGW) {
        int r = it;
        if (r < 3 * I_P) { const int w = r / I_P, q = r % I_P; const int db = q >> 3, kb = q & 7;
            transpose_item(w == 0 ? wpa : w == 1 ? wpb : wpm, 1024, 1536, db * 32, (bf16_t*)(ws + WS_WPC) + w * 512, db * 32, nullptr, scr, kb, lane); continue; }
        r -= 3 * I_P;
        if (r < I_O) { const int db = r >> 4, kb = r & 15; transpose_item(A.in[25], 1024, 1024, db * 32, (bf16_t*)(ws + WS_WO), db * 32, nullptr, scr, kb, lane); continue; }
        r -= I_O;
        if (r < I_UP) { const int db = r >> 4, kb = r & 15; transpose_item(A.in[27], 4096, 1024, db * 32, (bf16_t*)(ws + WS_WUP), db * 32, A.in[26], scr, kb, lane); continue; }
        r -= I_UP;
        { const int db = r >> 6, kb = r & 63; transpose_item(A.in[28], 1024, 4096, db * 32, (bf16_t*)(ws + WS_WDN), db * 32, nullptr, scr, kb, lane); }
    }
}

__device__ __forceinline__ void cumsum_seq(const Args& A, const float* out, unsigned char* ws, int seq, int lane) {
    const bool prompt = seq < 32; const int bh = prompt ? seq : seq - 32; const int b = bh >> 3, h = bh & 7;
    const int n = prompt ? SEQ : SLEN; const int per = (n + 63) / 64; const int start = lane * per;
    float* dst = prompt ? (float*)(ws + WS_CP) + (size_t)bh * SEQ : (float*)(ws + WS_CS) + (size_t)bh * SLEN;
    const float* clf = A.in[7];
#define CS_GET(i) (prompt ? out[O_LFP + ((size_t)b * SEQ + (i)) * 8 + h] : ((i) < PAST ? clf[((size_t)b * PAST + (i)) * 8 + h] : out[O_LFS + ((size_t)b * SSEQ + ((i) - PAST)) * 8 + h]))
    float s = 0.f;
    for (int i = 0; i < per; ++i) { const int idx = start + i; if (idx < n) s += CS_GET(idx); }
    float incl = s;
#pragma unroll
    for (int o = 1; o < 64; o <<= 1) { const float t = __shfl_up(incl, o); if (lane >= o) incl += t; }
    float run = incl - s;
    for (int i = 0; i < per; ++i) { const int idx = start + i; if (idx < n) { run += CS_GET(idx); dst[idx] = run * LOG2E; } }
}


template <int K, int LDA, int LDB> __device__ __forceinline__ f32x4 sg_tile(const bf16_t* Arow0, const bf16_t* Bcol0, LAS float* red) {
    const int tid = threadIdx.x, lane = tid & 63, r = lane & 31, hh = lane >> 5; const int wid = __builtin_amdgcn_readfirstlane(tid >> 6);
    constexpr int KW = K / 8, NS = KW / 16, UN = NS >= 8 ? 4 : NS / 2;
    static_assert(NS % (2 * UN) == 0, "sg_tile K");
    const bf16_t* ap = Arow0 + (size_t)r * LDA + wid * KW + 8 * hh;
    const bf16_t* b0 = Bcol0 + (size_t)r * LDB + wid * KW + 8 * hh;
    const bf16_t* b1 = b0 + (size_t)32 * LDB;
    f32x16 c0, c1;
#pragma unroll
    for (int i = 0; i < 16; ++i) { c0[i] = 0.f; c1[i] = 0.f; }
    bf16x8 fa[UN], fb0[UN], fb1[UN], ga[UN], gb0[UN], gb1[UN];
#pragma unroll
    for (int i = 0; i < UN; ++i) { fa[i] = *(const bf16x8*)(ap + i * 16); fb0[i] = *(const bf16x8*)(b0 + i * 16); fb1[i] = *(const bf16x8*)(b1 + i * 16); }
    for (int s0 = 0; s0 < NS; s0 += 2 * UN) {
#pragma unroll
        for (int i = 0; i < UN; ++i) { ga[i] = *(const bf16x8*)(ap + (s0 + UN + i) * 16); gb0[i] = *(const bf16x8*)(b0 + (s0 + UN + i) * 16); gb1[i] = *(const bf16x8*)(b1 + (s0 + UN + i) * 16); }
#pragma unroll
        for (int i = 0; i < UN; ++i) { c0 = MFMA32(fa[i], fb0[i], c0); c1 = MFMA32(fa[i], fb1[i], c1); }
        if (s0 + 2 * UN < NS) {
#pragma unroll
            for (int i = 0; i < UN; ++i) { fa[i] = *(const bf16x8*)(ap + (s0 + 2 * UN + i) * 16); fb0[i] = *(const bf16x8*)(b0 + (s0 + 2 * UN + i) * 16); fb1[i] = *(const bf16x8*)(b1 + (s0 + 2 * UN + i) * 16); }
        }
#pragma unroll
        for (int i = 0; i < UN; ++i) { c0 = MFMA32(ga[i], gb0[i], c0); c1 = MFMA32(ga[i], gb1[i], c1); }
    }
#pragma unroll
    for (int i = 0; i < 16; ++i) { const int row = (i & 3) + 8 * (i >> 2) + 4 * hh; red[(wid * 32 + row) * 64 + r] = c0[i]; red[(wid * 32 + row) * 64 + 32 + r] = c1[i]; }
    LDS_BAR();
    const int row = tid >> 4, c4 = (tid & 15) * 4;
    f32x4 v = *(const LAS f32x4*)(red + row * 64 + c4);
#pragma unroll
    for (int w = 1; w < 8; ++w) v += *(const LAS f32x4*)(red + (w * 32 + row) * 64 + c4);
    LDS_BAR();
    return v;
}
template <int K, int LDA, int LDB> __device__ __forceinline__ void sg_tile2(const bf16_t* Arow0, const bf16_t* Bcol0, LAS float* red, f32x4 (&v)[2]) {
    const int tid = threadIdx.x, lane = tid & 63, r = lane & 31, hh = lane >> 5; const int wid = __builtin_amdgcn_readfirstlane(tid >> 6);
    constexpr int KW = K / 8, NS = KW / 16, UN = NS >= 8 ? 4 : NS / 2;
    static_assert(NS % (2 * UN) == 0, "sg_tile2 K");
    const bf16_t* a0 = Arow0 + (size_t)r * LDA + wid * KW + 8 * hh;
    const bf16_t* a1 = a0 + (size_t)32 * LDA;
    const bf16_t* b0 = Bcol0 + (size_t)r * LDB + wid * KW + 8 * hh;
    const bf16_t* b1 = b0 + (size_t)32 * LDB;
    f32x16 c[2][2];
#pragma unroll
    for (int i = 0; i < 16; ++i) { c[0][0][i] = 0.f; c[0][1][i] = 0.f; c[1][0][i] = 0.f; c[1][1][i] = 0.f; }
    bf16x8 fa0[UN], fa1[UN], fb0[UN], fb1[UN], ga0[UN], ga1[UN], gb0[UN], gb1[UN];
#pragma unroll
    for (int i = 0; i < UN; ++i) { fa0[i] = *(const bf16x8*)(a0 + i * 16); fa1[i] = *(const bf16x8*)(a1 + i * 16); fb0[i] = *(const bf16x8*)(b0 + i * 16); fb1[i] = *(const bf16x8*)(b1 + i * 16); }
    for (int s0 = 0; s0 < NS; s0 += 2 * UN) {
#pragma unroll
        for (int i = 0; i < UN; ++i) { const int o = (s0 + UN + i) * 16; ga0[i] = *(const bf16x8*)(a0 + o); ga1[i] = *(const bf16x8*)(a1 + o); gb0[i] = *(const bf16x8*)(b0 + o); gb1[i] = *(const bf16x8*)(b1 + o); }
#pragma unroll
        for (int i = 0; i < UN; ++i) { c[0][0] = MFMA32(fa0[i], fb0[i], c[0][0]); c[0][1] = MFMA32(fa0[i], fb1[i], c[0][1]); c[1][0] = MFMA32(fa1[i], fb0[i], c[1][0]); c[1][1] = MFMA32(fa1[i], fb1[i], c[1][1]); }
        if (s0 + 2 * UN < NS) {
#pragma unroll
            for (int i = 0; i < UN; ++i) { const int o = (s0 + 2 * UN + i) * 16; fa0[i] = *(const bf16x8*)(a0 + o); fa1[i] = *(const bf16x8*)(a1 + o); fb0[i] = *(const bf16x8*)(b0 + o); fb1[i] = *(const bf16x8*)(b1 + o); }
        }
#pragma unroll
        for (int i = 0; i < UN; ++i) { c[0][0] = MFMA32(ga0[i], gb0[i], c[0][0]); c[0][1] = MFMA32(ga0[i], gb1[i], c[0][1]); c[1][0] = MFMA32(ga1[i], gb0[i], c[1][0]); c[1][1] = MFMA32(ga1[i], gb1[i], c[1][1]); }
    }
    const int row = tid >> 4, c4 = (tid & 15) * 4;
#pragma unroll
    for (int h = 0; h < 2; ++h) {
#pragma unroll
        for (int i = 0; i < 16; ++i) { const int rr = (i & 3) + 8 * (i >> 2) + 4 * hh; red[(wid * 32 + rr) * 64 + r] = c[h][0][i]; red[(wid * 32 + rr) * 64 + 32 + r] = c[h][1][i]; }
        LDS_BAR();
        f32x4 s = *(const LAS f32x4*)(red + row * 64 + c4);
#pragma unroll
        for (int w = 1; w < 8; ++w) s += *(const LAS f32x4*)(red + (w * 32 + row) * 64 + c4);
        v[h] = s;
        LDS_BAR();
    }
}
__device__ __forceinline__ f32x4 bf4_to_f32(u32x2 w) { f32x4 g; g[0] = __uint_as_float(w.x << 16); g[1] = __uint_as_float(w.x & 0xffff0000u); g[2] = __uint_as_float(w.y << 16); g[3] = __uint_as_float(w.y & 0xffff0000u); return g; }
__device__ __forceinline__ u32x2 f32_to_bf4(f32x4 v) { u32x2 w; w.x = pk2(v[0], v[1]); w.y = pk2(v[2], v[3]); return w; }
__device__ __forceinline__ void sample_merge(unsigned char* ws, LAS float* red, int t) {
    const int rt = t >> 4, ct = t & 15; const int row = MP + rt * 32 + (threadIdx.x >> 4), col = ct * 64 + (threadIdx.x & 15) * 4;
    const bf16_t* G = (const bf16_t*)(ws + WS_GT) + (size_t)row * 3072 + col;
    const bf16_t* oc = (const bf16_t*)(ws + WS_OC) + (size_t)(MP + rt * 32) * 1536; const bf16_t* wp = (const bf16_t*)(ws + WS_WPC) + (size_t)ct * 64 * 1536;
    f32x4 h = sg_tile<512, 1536, 1536>(oc, wp, red) * bf4_to_f32(*(const u32x2*)G);
    h += sg_tile<512, 1536, 1536>(oc + 512, wp + 512, red) * bf4_to_f32(*(const u32x2*)(G + 1024));
    h += sg_tile<512, 1536, 1536>(oc + 1024, wp + 1024, red) * bf4_to_f32(*(const u32x2*)(G + 2048));
    *(u32x2*)((bf16_t*)(ws + WS_H) + (size_t)row * 1024 + col) = f32_to_bf4(h);
}
__device__ __forceinline__ void sample_wo(const float* xs, float* out, unsigned char* ws, LAS float* red, int t) {
    const int rt = t >> 4, ct = t & 15; const int row = MP + rt * 32 + (threadIdx.x >> 4), col = ct * 64 + (threadIdx.x & 15) * 4;
    f32x4 v = sg_tile<1024, 1024, 1024>((const bf16_t*)(ws + WS_H) + (size_t)(MP + rt * 32) * 1024, (const bf16_t*)(ws + WS_WO) + (size_t)ct * 64 * 1024, red);
    v += *(const f32x4*)(xs + (size_t)(row - MP) * 1024 + col);
    *(u32x2*)((bf16_t*)(ws + WS_X1B) + (size_t)row * 1024 + col) = f32_to_bf4(v);
    float ss = (v[0] * v[0] + v[1] * v[1]) + (v[2] * v[2] + v[3] * v[3]);
    ss += __shfl_xor(ss, 1); ss += __shfl_xor(ss, 2); ss += __shfl_xor(ss, 4); ss += __shfl_xor(ss, 8);
    if ((threadIdx.x & 15) == 0) unsafeAtomicAdd((float*)(ws + WS_SSQ2) + row, ss);
}
__device__ __forceinline__ void sample_up(unsigned char* ws, LAS float* red, int p) {
    const int rp = p >> 6, ct = p & 63; const int col = ct * 64 + (threadIdx.x & 15) * 4;
    f32x4 v[2];
    sg_tile2<1024, 1024, 1024>((const bf16_t*)(ws + WS_X1B) + (size_t)(MP + rp * 64) * 1024, (const bf16_t*)(ws + WS_WUP) + (size_t)ct * 64 * 1024, red, v);
#pragma unroll
    for (int h = 0; h < 2; ++h) { const int row = MP + rp * 64 + h * 32 + (threadIdx.x >> 4);
        const float rs = 1.0f / sqrtf(((const float*)(ws + WS_SSQ2))[row] * (1.0f / 1024.0f) + EPS); f32x4 x = v[h];
#pragma unroll
        for (int i = 0; i < 4; ++i) { float a = fmaxf(x[i] * rs, 0.f); x[i] = a * a; }
        *(u32x2*)((bf16_t*)(ws + WS_HF) + (size_t)row * 4096 + col) = f32_to_bf4(x); }
}
__device__ __forceinline__ void sample_down(float* out, unsigned char* ws, LAS float* red, int t) {
    const int rt = t >> 4, ct = t & 15; const int row = MP + rt * 32 + (threadIdx.x >> 4), col = ct * 64 + (threadIdx.x & 15) * 4;
    f32x4 v = sg_tile<4096, 4096, 4096>((const bf16_t*)(ws + WS_HF) + (size_t)(MP + rt * 32) * 4096, (const bf16_t*)(ws + WS_WDN) + (size_t)ct * 64 * 4096, red);
    *(f32x4*)(out + (size_t)row * 1024 + col) = v + bf4_to_f32(*(const u32x2*)((const bf16_t*)(ws + WS_X1B) + (size_t)row * 1024 + col));
}
struct SchedIn {
    pg8::StaticOrder so;
    __device__ bool next(int i, pg8::Unit& u) const {
        const long L = (long)i * so.G + so.c;
        if (L < so.nwg) return so.next(i, u);
        const int e = (int)(L - so.nwg); if (e >= 16) return false;
        u.pm = MT / 256 + (e >> 2); u.pn = NIN / 256 + (e & 3); return true;
    }
    __device__ __forceinline__ void a_ready(const pg8::Unit&) const {}
    __device__ __forceinline__ void done(const pg8::Unit&) const {}
};

#define XB_TMO      128
#define XB_XCNT(j)  (256  + 64 * (j))
#define XB_XSUB(j)  (1280 + 64 * (j))
#define XB_XGEN(j)  (2304 + 64 * (j))
#define XB_TOP      3328
#define XB_TOPGEN   3392
#define XCD_BAR_WORDS 3456
#define XB_SPIN_CAP (1u << 18)

__device__ __forceinline__ unsigned xb_ld(unsigned* p)              { return __hip_atomic_load(p, __ATOMIC_RELAXED, __HIP_MEMORY_SCOPE_AGENT); }
__device__ __forceinline__ unsigned xb_add(unsigned* p, unsigned v) { return __hip_atomic_fetch_add(p, v, __ATOMIC_RELAXED, __HIP_MEMORY_SCOPE_AGENT); }
__device__ __forceinline__ unsigned xb_xcc_id() { return (unsigned)__builtin_amdgcn_s_getreg((3 << 11) | 20) & 0xFu; }
#define XB_SPIN(cond, bar) do { unsigned _sp = 0; while (cond) { __builtin_amdgcn_s_sleep(1); \
    if ((++_sp & 255u) == 0u) { if (xb_ld(&(bar)[XB_TMO])) break; if (_sp > XB_SPIN_CAP) { atomicAdd(&(bar)[XB_TMO], 1u); break; } } } } while (0)

struct XcdBarrier {
    unsigned* bar; unsigned x;
    volatile LAS unsigned* st;
};

__device__ __forceinline__ XcdBarrier xcd_barrier_post(unsigned* bar, volatile LAS unsigned* st) {
    XcdBarrier b; b.bar = bar; b.x = xb_xcc_id(); b.st = st;
    if (threadIdx.x == 0) (void)xb_add(&bar[XB_XCNT(b.x)], 1u);
    return b;
}
__device__ __forceinline__ void xcd_barrier_complete(unsigned* bar, unsigned x, unsigned& nloc, unsigned& nx) {
    const unsigned G = gridDim.x * gridDim.y * gridDim.z;
    unsigned sum, cnt, mine, sp = 0u;
    for (;;) {
        sum = 0u; cnt = 0u; mine = 0u;
#pragma unroll
        for (unsigned j = 0; j < 16; ++j) { const unsigned c = xb_ld(&bar[XB_XCNT(j)]); sum += c; cnt += (c > 0u) ? 1u : 0u; mine = (j == x) ? c : mine; }
        if (sum == G) break;
        __builtin_amdgcn_s_sleep(1);
        if ((++sp & 255u) == 0u) { if (xb_ld(&bar[XB_TMO])) break; if (sp > XB_SPIN_CAP) { atomicAdd(&bar[XB_TMO], 1u); break; } }
    }
    nloc = mine > 0u ? mine : 1u; nx = cnt > 0u ? cnt : 1u;
}

__device__ __forceinline__ void xcd_barrier(const XcdBarrier& b) {
    asm volatile("s_waitcnt vmcnt(0)" ::: "memory");
    __syncthreads();
    if (threadIdx.x == 0) {
        unsigned* bar = b.bar;
        __builtin_amdgcn_s_waitcnt(0);
        unsigned nloc = b.st[0], nx = b.st[1];
        if (nloc == 0u) { xcd_barrier_complete(bar, b.x, nloc, nx); b.st[0] = nloc; b.st[1] = nx; }
        const unsigned old = xb_add(&bar[XB_XSUB(b.x)], 1u);
        const unsigned gen = old / nloc;
        if (old + 1u == (gen + 1u) * nloc) {
            __builtin_amdgcn_fence(__ATOMIC_RELEASE, "agent");
            asm volatile("s_waitcnt vmcnt(0)" ::: "memory");
            const unsigned og = xb_add(&bar[XB_TOP], 1u);
            const unsigned tg = og / nx;
            if (og + 1u == (tg + 1u) * nx) xb_add(&bar[XB_TOPGEN], 1u);
            else XB_SPIN(xb_ld(&bar[XB_TOPGEN]) == tg, bar);
            __builtin_amdgcn_fence(__ATOMIC_ACQUIRE, "agent");
            xb_add(&bar[XB_XGEN(b.x)], 1u);
            asm volatile("s_waitcnt vmcnt(0)" ::: "memory");
        } else {
            XB_SPIN(xb_ld(&bar[XB_XGEN(b.x)]) == gen, bar);
            __builtin_amdgcn_fence(__ATOMIC_ACQUIRE, "agent");
            asm volatile("s_waitcnt vmcnt(0)" ::: "memory");
        }
    }
    __syncthreads();
}

__device__ unsigned g_xbar[XCD_BAR_WORDS + 64];

constexpr int LDS_BYTES = 131072 + 1024;
__global__ void __launch_bounds__(512, 2) mega_fwd(Args args) {
    extern __shared__ __attribute__((aligned(16))) unsigned char lds_raw[];
    cg::grid_group grid = cg::this_grid();
    LAS unsigned char* lds = (LAS unsigned char*)lds_raw;
    const Args& A = args; float* out = args.out; unsigned char* ws = args.ws;
    const int lo = args.ph_lo, hi = args.ph_hi;
    const int G = gridDim.x, bx = blockIdx.x;
#ifndef PHMASK
#define PHMASK 127
#endif
#define IN(k) (((PHMASK >> (k)) & 1) && lo <= (k) && (k) < hi)
#define REP(k) for (int rep_ = 0; rep_ < (((DUPMASK >> (k)) & 1) ? 2 : 1); ++rep_)
    static_assert(XCD_BAR_WORDS == 3456, "barrier words");
    volatile LAS unsigned* bst = (volatile LAS unsigned*)(lds + 131072);
    if (threadIdx.x == 0) { bst[0] = 0u; bst[1] = 0u; }
    __syncthreads();
    const bool use_xb = (lo == 0 && hi == 7);
    XcdBarrier xbar; xbar.bar = g_xbar; xbar.x = 0; xbar.st = bst;
    if (use_xb) xbar = xcd_barrier_post(g_xbar, bst);
#define SEAM(k) do { if (IN(k) && IN((k) + 1)) { if (!use_xb) grid.sync(); else xcd_barrier(xbar); } } while (0)
    if (IN(0)) REP(0) { prologue(A, out, ws, (LAS char*)lds); }
    SEAM(0);
    if (IN(1)) REP(1) {
        { pg8::Gemm g{(const bf16_t*)(ws + WS_XB), (const bf16_t*)(ws + WS_WIN), MT, NIN, 1024}; SchedIn S; S.so.init(MT, NIN, G, bx);
          EpiIn E{(const float*)(ws + WS_RSTD1), out, ws, A.in[13], A.in[14], A.in[15], A.in[16], A.in[17]};
          pg8::gemm_phase<EpiIn, SchedIn, true, true>(lds, g, S, E); }
        { const int wave = __builtin_amdgcn_readfirstlane(threadIdx.x >> 6); const int first = G > 60 ? G - 60 : 0;
          if (bx >= first) { for (int seq = (bx - first) * 8 + wave; seq < 288; seq += (G - first) * 8) cumsum_seq(A, out, ws, seq, threadIdx.x & 63);
                             late_weights(A, ws, (LAS char*)lds, (bx - first) * 8 + wave, (G - first) * 8); } }
    }
    SEAM(1);
    if (IN(2)) { attention_phase(A, out, ws, (LAS char*)lds, 0);
#if (DUPMASK >> 2) & 1
        attention_phase(A, out, ws, (LAS char*)lds, 1);
#endif
    }
    SEAM(2);
    if (IN(3)) {
        for (int t = bx; t < 256; t += G) sample_merge(ws, (LAS float*)lds, t);
        pg8::StaticOrder S; S.init(MP, 1024, G, bx);
        pg8::Gemm g{(const bf16_t*)(ws + WS_OC), (const bf16_t*)(ws + WS_WPC), MP, 1024, 1536}; EpiMergeH E{ws}; pg8::gemm_phase<EpiMergeH, pg8::StaticOrder, true, true>(lds, g, S, E);
#if (DUPMASK >> 3) & 1
        pg8::gemm_phase<EpiMergeH, pg8::StaticOrder, true, true>(lds, g, S, E);
#endif
    }
    SEAM(3);
    if (IN(4)) { for (int t = bx; t < 256; t += G) sample_wo(A.in[1], out, ws, (LAS float*)lds, t);
        pg8::Gemm g{(const bf16_t*)(ws + WS_H), (const bf16_t*)(ws + WS_WO), MP, 1024, 1024}; pg8::StaticOrder S; S.init(MP, 1024, G, bx);
#if (DUPMASK >> 4) & 1
        { EpiWo E0{A.in[0], A.in[1], (float*)(ws + WS_QA), (bf16_t*)(ws + WS_QA + ((size_t)80 << 20)), (float*)(ws + WS_QA + ((size_t)120 << 20))}; pg8::gemm_phase<EpiWo, pg8::StaticOrder, true, true>(lds, g, S, E0); }
#endif
        EpiWo E{A.in[0], A.in[1], out, (bf16_t*)(ws + WS_X1B), (float*)(ws + WS_SSQ2)}; pg8::gemm_phase<EpiWo, pg8::StaticOrder, true, true>(lds, g, S, E); }
    SEAM(4);
    if (IN(5)) { for (int t = bx; t < 512; t += G) sample_up(ws, (LAS float*)lds, t);
        pg8::Gemm g{(const bf16_t*)(ws + WS_X1B), (const bf16_t*)(ws + WS_WUP), MP, 4096, 1024}; pg8::StaticOrder S; S.init(MP, 4096, G, bx);
        EpiUp E{ws}; pg8::gemm_phase<EpiUp, pg8::StaticOrder, true, true>(lds, g, S, E);
#if (DUPMASK >> 5) & 1
        pg8::gemm_phase<EpiUp, pg8::StaticOrder, true, true>(lds, g, S, E);
#endif
    }
    SEAM(5);
    if (IN(6)) { for (int t = bx; t < 256; t += G) sample_down(out, ws, (LAS float*)lds, t);
        pg8::Gemm g{(const bf16_t*)(ws + WS_HF), (const bf16_t*)(ws + WS_WDN), MP, 1024, 4096}; pg8::StaticOrder S; S.init(MP, 1024, G, bx);
#if (DUPMASK >> 6) & 1
        { EpiDown E0{(float*)(ws + WS_OC), (const bf16_t*)(ws + WS_X1B)}; pg8::gemm_phase<EpiDown, pg8::StaticOrder, true, true>(lds, g, S, E0); }
#endif
        EpiDown E{out, (const bf16_t*)(ws + WS_X1B)}; pg8::gemm_phase<EpiDown, pg8::StaticOrder, true, true>(lds, g, S, E); }
    if (use_xb) {
        __syncthreads();
        if (threadIdx.x == 0) { __threadfence(); const unsigned old = atomicAdd(&g_xbar[XCD_BAR_WORDS], 1u); bst[0] = (old == gridDim.x - 1) ? 1u : 0u; }
        __syncthreads();
        if (bst[0]) { for (int i = threadIdx.x; i < XCD_BAR_WORDS + 64; i += 512) g_xbar[i] = 0u; }
    }
#undef IN
#undef SEAM
}

#ifndef MK_SPLIT
#define MK_SPLIT 0
#endif
extern "C" void kernel_launch(void* const* d_in, const int* in_sizes, int n_in, void* d_out, int out_size, void* d_ws, size_t ws_size, hipStream_t stream) {
    static int grid = 0;
    if (grid == 0) {
        if (n_in != 29 || out_size != (int)O_END || ws_size < WS_END) { fprintf(stderr, "kernel_launch: unexpected shapes (n_in %d out %d ws %zu need %zu)\n", n_in, out_size, ws_size, (size_t)WS_END); grid = -1; return; }
        int dev = 0, cus = 0, per_cu = 0;
        hipGetDevice(&dev); hipDeviceGetAttribute(&cus, hipDeviceAttributeMultiprocessorCount, dev);
        if (hipFuncSetAttribute((const void*)mega_fwd, hipFuncAttributeMaxDynamicSharedMemorySize, LDS_BYTES) != hipSuccess) { fprintf(stderr, "kernel_launch: hipFuncSetAttribute failed\n"); grid = -1; return; }
        if (hipOccupancyMaxActiveBlocksPerMultiprocessor(&per_cu, (const void*)mega_fwd, 512, LDS_BYTES) != hipSuccess || per_cu < 1) { fprintf(stderr, "kernel_launch: occupancy query failed (%d)\n", per_cu); (void)hipGetLastError(); per_cu = 1; }
        grid = cus * 1;
        if (grid <= 0) grid = 256;
    }
    if (grid < 0) return;
    Args a{};
    for (int i = 0; i < 29; ++i) a.in[i] = (const float*)d_in[i];
    a.out = (float*)d_out; a.ws = (unsigned char*)d_ws;
#if MK_SPLIT
    for (int p = 0; p < 7; ++p) { a.ph_lo = p; a.ph_hi = p + 1; hipLaunchKernelGGL(mega_fwd, dim3(grid), dim3(512), LDS_BYTES, stream, a); }
#else
    a.ph_lo = 0; a.ph_hi = 7;
    void* kargs[] = {&a};
    hipError_t e = hipLaunchCooperativeKernel((const void*)mega_fwd, dim3(grid), dim3(512), kargs, LDS_BYTES, stream);
    if (e != hipSuccess) fprintf(stderr, "cooperative launch failed: %s (grid %d)\n", hipGetErrorString(e), grid);
#endif
}
```

```cpp
#include <hip/hip_runtime.h>
#include <hip/hip_cooperative_groups.h>
#include <cstdio>
#include <cstdint>
namespace cg = cooperative_groups;
#ifndef DUPMASK
#define DUPMASK 0
#endif
namespace pg8 {
#define PG8_LAS __attribute__((address_space(3)))
typedef unsigned short bf16_t;
typedef short bf16x8 __attribute__((ext_vector_type(8)));
typedef float f32x4 __attribute__((ext_vector_type(4)));
typedef unsigned u32x4 __attribute__((ext_vector_type(4)));
constexpr int BM = 256, BK = 64, HALF = 128, HTB = HALF * BK * 2  , STAGE_BYTES = 8 * HTB, NXCD = 8, WGM = 8;

__host__ __device__ __forceinline__ int lds_byte(int r, int c) { const int st = (r >> 4) * 2 + (c >> 5), rr = r & 15, cc = c & 31, ob = rr * 64 + cc * 2; return st * 1024 + (ob ^ (((ob >> 9) & 1) << 5)); }
__host__ __device__ __forceinline__ void stage_rc(int b, int& R, int& C) { const int st = b / 1024, sb = b % 1024, swz = sb ^ (((sb >> 9) & 1) << 5); R = (st >> 1) * 16 + swz / 64; C = (st & 1) * 32 + (swz % 64) / 2; }
__host__ __device__ __forceinline__ int perm32(int rho) { const int n = rho >> 4, i = rho & 15; return 8 * (i >> 2) + 4 * n + (i & 3); }

struct Unit { int pm, pn; };
struct Gemm { const bf16_t* A; const bf16_t* Bt; int M, N, K; };

struct StaticOrder {
    int nM, nN, nwg, G, c;
    __host__ __device__ void init(int M, int N, int G_, int c_) { nM = M / BM; nN = N / BM; nwg = nM * nN; G = G_; c = c_; }
    __host__ __device__ bool next(int i, Unit& u) const {
        const long L = (long)i * G + c; if (L >= nwg) return false;
        int wgid = (int)L; { const int q = nwg / NXCD, r = nwg % NXCD, xcd = wgid % NXCD, off = wgid / NXCD; wgid = (xcd < r ? xcd * (q + 1) : r * (q + 1) + (xcd - r) * q) + off; }
        const int nig = WGM * nN, gid = wgid / nig, fm = gid * WGM, gsz = (nM - fm) < WGM ? (nM - fm) : WGM;
        u.pm = fm + ((wgid % nig) % gsz); u.pn = (wgid % nig) / gsz; return true;
    }
    __device__ __forceinline__ void a_ready(const Unit&) const {}
    __device__ __forceinline__ void done(const Unit&) const {}
};

__device__ __forceinline__ unsigned cvt_pk_bf16(float lo, float hi) { unsigned r; asm volatile("v_cvt_pk_bf16_f32 %0, %1, %2" : "=v"(r) : "v"(lo), "v"(hi)); return r; }
typedef float f32x2 __attribute__((ext_vector_type(2)));
template <class Epi, class Sched, bool ALIGN_EPI = false, bool SP2 = false>
__device__ __forceinline__ void gemm_phase(PG8_LAS unsigned char* lds, const Gemm g, const Sched& S, const Epi& E) {
    const int tid = threadIdx.x, wid = __builtin_amdgcn_readfirstlane(tid >> 6), lane = tid & 63, wr = wid >> 2, wc = wid & 3, fr = lane & 15, fq = lane >> 4;
    const int K = g.K, nt = K / BK;
    unsigned voffA[2], voffB[2];
#pragma unroll
    for (int i = 0; i < 2; ++i) { int R, C; stage_rc(tid * 16 + i * 8192, R, C); const int Rb = Epi::PERM ? ((R & ~31) + perm32(R & 31)) : R;
        voffA[i] = (unsigned)(R * K + C) * 2u; voffB[i] = (unsigned)(Rb * K + C) * 2u; }
    const size_t kstep = (size_t)(BK * 2);
    const size_t hstep = (size_t)HALF * K * 2;
    const size_t tstep = 2 * hstep;
    const unsigned ldsw = (unsigned)wid * 1024u;
    const int aoff = lds_byte(wr * 64 + fr, fq * 8), boff = lds_byte(wc * 32 + fr, fq * 8);
#define PG8_SA(b, h) (((b) * 2 + (h)) * HTB)
#define PG8_SB(b, h) ((4 + (b) * 2 + (h)) * HTB)
#define PG8_STAGE(bufoff, gbase, voff) do { _Pragma("unroll") for (int _i = 0; _i < 2; ++_i) \
        __builtin_amdgcn_global_load_lds((const unsigned*)((const char*)(gbase) + (voff)[_i]), (PG8_LAS unsigned*)(lds + (bufoff) + ldsw + _i * 8192), 16, 0, 0); } while (0)
#define PG8_LDA(dst, b, h) do { _Pragma("unroll") for (int m = 0; m < 4; ++m) _Pragma("unroll") for (int k = 0; k < 2; ++k) dst[m][k] = *(const PG8_LAS bf16x8*)(lds + PG8_SA(b, h) + aoff + m * 2048 + k * 1024); } while (0)
#define PG8_LDB(dst, b, h) do { _Pragma("unroll") for (int n = 0; n < 2; ++n) _Pragma("unroll") for (int k = 0; k < 2; ++k) dst[n][k] = *(const PG8_LAS bf16x8*)(lds + PG8_SB(b, h) + boff + n * 2048 + k * 1024); } while (0)
#define PG8_MMA(ai, bj, At, Bt) do { __builtin_amdgcn_s_setprio(1); _Pragma("unroll") for (int m = 0; m < 4; ++m) _Pragma("unroll") for (int n = 0; n < 2; ++n) _Pragma("unroll") for (int k = 0; k < 2; ++k) \
        acc[ai][bj][m][n] = __builtin_amdgcn_mfma_f32_16x16x32_bf16(Bt[n][k], At[m][k], acc[ai][bj][m][n], 0, 0, 0); __builtin_amdgcn_s_setprio(0); } while (0)
#define PG8_WAIT_V(n) asm volatile("s_waitcnt vmcnt(" #n ")" ::: "memory")
#define PG8_WAIT_L(n) asm volatile("s_waitcnt lgkmcnt(" #n ")" ::: "memory")
#define PG8_BAR __builtin_amdgcn_s_barrier()
#define PG8_SCHED __builtin_amdgcn_sched_barrier(0)
    Unit cur, nxt; int ui = 0;
    if (!S.next(0, cur)) return;
    f32x4 acc[2][2][4][2];
#pragma unroll
    for (int a = 0; a < 2; ++a)
#pragma unroll
        for (int b = 0; b < 2; ++b)
#pragma unroll
            for (int m = 0; m < 4; ++m)
#pragma unroll
                for (int n = 0; n < 2; ++n) acc[a][b][m][n] = (f32x4){0.f, 0.f, 0.f, 0.f};
    bf16x8 At[4][2], B0[2][2], B1[2][2];
    const char* cA = (const char*)g.A + (size_t)cur.pm * tstep; const char* cB = (const char*)g.Bt + (size_t)cur.pn * tstep;
    S.a_ready(cur);
    if constexpr (SP2) {
        PG8_STAGE(PG8_SB(0, 0), cB, voffB); PG8_STAGE(PG8_SB(0, 1), cB + hstep, voffB); PG8_STAGE(PG8_SA(0, 0), cA, voffA); PG8_STAGE(PG8_SA(0, 1), cA + hstep, voffA);
        if (wr == 1) PG8_BAR;
        PG8_WAIT_V(2); PG8_BAR;
        PG8_STAGE(PG8_SB(1, 0), cB + kstep, voffB); PG8_STAGE(PG8_SA(1, 0), cA + kstep, voffA); PG8_STAGE(PG8_SB(1, 1), cB + hstep + kstep, voffB);
        PG8_WAIT_V(6); PG8_BAR;
    } else {
        PG8_STAGE(PG8_SB(0, 0), cB, voffB); PG8_STAGE(PG8_SA(0, 0), cA, voffA); PG8_STAGE(PG8_SB(0, 1), cB + hstep, voffB); PG8_STAGE(PG8_SA(0, 1), cA + hstep, voffA);
        if (wr == 1) PG8_BAR;
        PG8_WAIT_V(4); PG8_BAR;
        PG8_STAGE(PG8_SB(1, 0), cB + kstep, voffB); PG8_STAGE(PG8_SA(1, 0), cA + kstep, voffA); PG8_STAGE(PG8_SB(1, 1), cB + hstep + kstep, voffB);
        PG8_WAIT_V(6); PG8_BAR;
    }
    for (;;) {
        const bool has_next = S.next(ui + 1, nxt);
        const char* nA = has_next ? (const char*)g.A + (size_t)nxt.pm * tstep : cA; const char* nB = has_next ? (const char*)g.Bt + (size_t)nxt.pn * tstep : cB;
        for (int t = 0; t < nt; t += 2) {
            if constexpr (Epi::MID) { if (t == 8 || t == 16) E.mid(acc, cur, t, wr, wc, fr, fq); }
            const bool last = (t == nt - 2);
            const char* a1 = cA + (size_t)(t + 1) * kstep;
            const char* a2 = last ? nA : cA + (size_t)(t + 2) * kstep; const char* b2 = last ? nB : cB + (size_t)(t + 2) * kstep;
            const char* a3 = a2 + kstep; const char* b3 = b2 + kstep;
            if (last && has_next) S.a_ready(nxt);
            if constexpr (SP2) {
            PG8_LDB(B0, 0, 0); PG8_LDB(B1, 0, 1); PG8_SCHED; PG8_LDA(At, 0, 0); PG8_STAGE(PG8_SA(1, 1), a1 + hstep, voffA);
            PG8_WAIT_V(8); PG8_WAIT_L(0); PG8_BAR; PG8_MMA(0, 0, At, B0); PG8_MMA(0, 1, At, B1); PG8_BAR; PG8_SCHED;
            PG8_LDA(At, 0, 1); PG8_STAGE(PG8_SB(0, 0), b2, voffB); PG8_STAGE(PG8_SB(0, 1), b2 + hstep, voffB); PG8_STAGE(PG8_SA(0, 0), a2, voffA);
            PG8_WAIT_V(8); PG8_WAIT_L(0); PG8_BAR; PG8_MMA(1, 0, At, B0); PG8_MMA(1, 1, At, B1); PG8_BAR; PG8_SCHED;
            PG8_LDB(B0, 1, 0); PG8_LDB(B1, 1, 1); PG8_SCHED; PG8_LDA(At, 1, 0); PG8_STAGE(PG8_SA(0, 1), a2 + hstep, voffA);
            PG8_WAIT_V(8); PG8_WAIT_L(0); PG8_BAR; PG8_MMA(0, 0, At, B0); PG8_MMA(0, 1, At, B1); PG8_BAR; PG8_SCHED;
            PG8_LDA(At, 1, 1); PG8_STAGE(PG8_SB(1, 0), b3, voffB); PG8_STAGE(PG8_SB(1, 1), b3 + hstep, voffB); PG8_STAGE(PG8_SA(1, 0), a3, voffA);
            PG8_WAIT_V(8); PG8_WAIT_L(0); PG8_BAR; PG8_MMA(1, 0, At, B0); PG8_MMA(1, 1, At, B1); PG8_BAR; PG8_SCHED;
            } else {
            PG8_LDB(B0, 0, 0); PG8_SCHED; PG8_LDA(At, 0, 0); PG8_STAGE(PG8_SA(1, 1), a1 + hstep, voffA);
            PG8_WAIT_L(8); PG8_BAR; PG8_WAIT_L(0); PG8_MMA(0, 0, At, B0); PG8_BAR; PG8_SCHED;
            PG8_LDB(B1, 0, 1); PG8_STAGE(PG8_SB(0, 0), b2, voffB);
            PG8_BAR; PG8_WAIT_L(0); PG8_MMA(0, 1, At, B1); PG8_BAR;
            PG8_LDA(At, 0, 1); PG8_STAGE(PG8_SA(0, 0), a2, voffA);
            PG8_BAR; PG8_WAIT_L(0); PG8_MMA(1, 0, At, B0); PG8_BAR; PG8_SCHED;
            PG8_STAGE(PG8_SB(0, 1), b2 + hstep, voffB);
            PG8_WAIT_V(6); PG8_BAR; PG8_MMA(1, 1, At, B1); PG8_BAR;
            PG8_LDB(B0, 1, 0); PG8_SCHED; PG8_LDA(At, 1, 0); PG8_STAGE(PG8_SA(0, 1), a2 + hstep, voffA);
            PG8_WAIT_L(8); PG8_BAR; PG8_WAIT_L(0); PG8_MMA(0, 0, At, B0); PG8_BAR; PG8_SCHED;
            PG8_LDB(B1, 1, 1); PG8_STAGE(PG8_SB(1, 0), b3, voffB);
            PG8_BAR; PG8_WAIT_L(0); PG8_MMA(0, 1, At, B1); PG8_BAR;
            PG8_LDA(At, 1, 1); PG8_STAGE(PG8_SA(1, 0), a3, voffA);
            PG8_BAR; PG8_WAIT_L(0); PG8_MMA(1, 0, At, B0); PG8_BAR; PG8_SCHED;
            PG8_STAGE(PG8_SB(1, 1), b3 + hstep, voffB);
            PG8_WAIT_V(6); PG8_BAR; PG8_MMA(1, 1, At, B1); PG8_BAR;
            }
        }
        if constexpr (ALIGN_EPI) { if (wr == 0) PG8_BAR; }
        if constexpr (!Epi::AFTER_DRAIN) { E(acc, cur, wr, wc, fr, fq); S.done(cur); }
        if (!has_next) break;
#pragma unroll
        for (int a = 0; a < 2; ++a)
#pragma unroll
            for (int b = 0; b < 2; ++b)
#pragma unroll
                for (int m = 0; m < 4; ++m)
#pragma unroll
                    for (int n = 0; n < 2; ++n) acc[a][b][m][n] = (f32x4){0.f, 0.f, 0.f, 0.f};
        cur = nxt; cA = nA; cB = nB; ++ui;
        if constexpr (ALIGN_EPI) { if (wr == 1) PG8_BAR; }
    }
    PG8_WAIT_V(0);
    if constexpr (!ALIGN_EPI) { if (wr == 0) PG8_BAR; }
    PG8_BAR;
    if constexpr (Epi::AFTER_DRAIN) { E.fused(acc, cur, wr, wc, fr, fq, lds, wid, lane); S.done(cur); }
#undef PG8_SA
#undef PG8_SB
#undef PG8_STAGE
#undef PG8_LDA
#undef PG8_LDB
#undef PG8_MMA
#undef PG8_WAIT_V
#undef PG8_WAIT_L
#undef PG8_BAR
#undef PG8_SCHED
}
}

#define LAS __attribute__((address_space(3)))
typedef unsigned short bf16_t;
typedef short bf16x8 __attribute__((ext_vector_type(8)));
typedef short s16x4 __attribute__((ext_vector_type(4)));
typedef float f32x4 __attribute__((ext_vector_type(4)));
typedef float f32x16 __attribute__((ext_vector_type(16)));
typedef unsigned u32x4 __attribute__((ext_vector_type(4)));
typedef unsigned u32x2 __attribute__((ext_vector_type(2)));
typedef float f32x2 __attribute__((ext_vector_type(2)));
typedef __bf16 bf16x2_t __attribute__((ext_vector_type(2)));

constexpr int DM = 1024, SEQ = 4096, NBATCH = 4, MP = NBATCH * SEQ, SBATCH = 32, SSEQ = 16, MS = SBATCH * SSEQ, MT = MP + MS;
constexpr int PAST = 2048, ACACHE = 512, NMEM = 256, DFF = 4096, NIN = 6656, DIN = 6664, KEEP = 512;
constexpr float EPS = 1e-6f, LOG2E = 1.4426950408889634f;
constexpr int SLEN = PAST + SSEQ;

constexpr size_t O_YP = 0, O_YS = O_YP + (size_t)MP * DM, O_AKP = O_YS + (size_t)MS * DM, O_AVP = O_AKP + (size_t)NBATCH * KEEP * 512,
    O_BKP = O_AVP + (size_t)NBATCH * KEEP * 512, O_BVP = O_BKP + (size_t)MP * 512, O_LFP = O_BVP + (size_t)MP * 512, O_MKP = O_LFP + (size_t)MP * 8,
    O_MVP = O_MKP + (size_t)NBATCH * NMEM * 512, O_AKS = O_MVP + (size_t)NBATCH * NMEM * 512, O_AVS = O_AKS + (size_t)MS * 512, O_BKS = O_AVS + (size_t)MS * 512,
    O_BVS = O_BKS + (size_t)MS * 512, O_LFS = O_BVS + (size_t)MS * 512, O_END = O_LFS + (size_t)MS * 8;
static_assert(O_END == 38408192, "output size");

constexpr size_t al256(size_t x) { return (x + 255) & ~(size_t)255; }
constexpr size_t WS_CTL = 0, WS_BAR = 4096  , WS_RSTD1 = 20480, WS_RSTDM = WS_RSTD1 + MT * 4  , WS_SSQ2 = al256(WS_RSTDM + 1024 * 4), WS_PARTQ = al256(WS_SSQ2 + MT * 4),
    WS_PARTK = al256(WS_PARTQ + (size_t)MT * 8 * 4), WS_CP = al256(WS_PARTK + 1024 * 8 * 4), WS_CS = al256(WS_CP + 32 * 4096 * 4), WS_MKRAW = al256(WS_CS + 256 * SLEN * 4),
    WS_MVB = al256(WS_MKRAW + 1024 * 512 * 4), WS_WIN = al256(WS_MVB + 1024 * 512 * 2), WS_WMKV = WS_WIN + (size_t)NIN * 1024 * 2  ,
    WS_WPC = al256(WS_WMKV + 1024 * 1024 * 2)  , WS_WO = al256(WS_WPC + 1024 * 1536 * 2),
    WS_WUP = al256(WS_WO + 1024 * 1024 * 2), WS_WDN = al256(WS_WUP + (size_t)4096 * 1024 * 2), WS_XB = al256(WS_WDN + (size_t)4096 * 1024 * 2),
    WS_MB = WS_XB + (size_t)MT * 1024 * 2  , WS_OC = al256(WS_MB + 1024 * 1024 * 2)  ,
    WS_H = al256(WS_OC + (size_t)MT * 1536 * 2), WS_X1B = al256(WS_H + (size_t)MT * 1024 * 2),
    WS_QA = al256(WS_X1B + (size_t)MT * 1024 * 2), WS_KA = al256(WS_QA + (size_t)MT * 512 * 2), WS_VA = al256(WS_KA + (size_t)MT * 512 * 2), WS_QB = al256(WS_VA + (size_t)MT * 512 * 2),
    WS_KB = al256(WS_QB + (size_t)MT * 512 * 2), WS_VB = al256(WS_KB + (size_t)MT * 512 * 2), WS_QM = al256(WS_VB + (size_t)MT * 512 * 2), WS_GT = al256(WS_QM + (size_t)MT * 512 * 2),
    WS_ZEND = al256(WS_GT + (size_t)MT * 3072 * 2), WS_HF = WS_QA  , WS_END = WS_ZEND;
static_assert(WS_HF + (size_t)MT * 4096 * 2 <= WS_ZEND, "HF overlay fits");
static_assert(WS_RSTDM % 256 == 0 && WS_WMKV % 256 == 0 && WS_MB % 256 == 0, "contiguous tails stay aligned");

struct Args { const float* in[29]; float* out; unsigned char* ws; int ph_lo, ph_hi; };

__device__ __forceinline__ unsigned f2bf(float f) { unsigned u = __builtin_bit_cast(unsigned, f); return (u + 0x7fffu + ((u >> 16) & 1u)) >> 16; }
__device__ __forceinline__ unsigned pk2(float lo, float hi) { f32x2 v = {lo, hi}; bf16x2_t b = __builtin_convertvector(v, bf16x2_t); return __builtin_bit_cast(unsigned, b); }
__device__ __forceinline__ float wave_sum(float v) {
#pragma unroll
    for (int o = 1; o < 64; o <<= 1) v += __shfl_xor(v, o);
    return v;
}
__device__ __forceinline__ const float* opq(const float* p) { asm volatile("" : "+s"(p)); return p; }
__device__ __forceinline__ float fast_sigmoid(float x) { return __builtin_amdgcn_rcpf(1.0f + __builtin_amdgcn_exp2f(-x * LOG2E)); }

typedef pg8::f32x4 af4;
#define EPI_ARGS const af4 (&acc)[2][2][4][2], const pg8::Unit& u, int wr, int wc, int fr, int fq

struct EpiIn {
    static constexpr bool PERM = true, AFTER_DRAIN = false, MID = false;
    const float* rstd; float* out; unsigned char* ws; const float *g_qa, *g_ka, *g_qb, *g_kb, *g_qm;
    __device__ __forceinline__ void mkv(EPI_ARGS) const {
        const int pn = u.pn - 26, pm = u.pm; const int rbase = pm * 256 + wr * 64 + fr - MT;
        const float* rstdm = rstd + MT; const int colS = (pn & 1) * 256 + wc * 64 + 8 * fq;
        float rsv[2][4];
#pragma unroll
        for (int ai = 0; ai < 2; ++ai)
#pragma unroll
            for (int m = 0; m < 4; ++m) rsv[ai][m] = rstdm[rbase + ai * 128 + m * 16];
        float* mk = (float*)(ws + WS_MKRAW); float* part = (float*)(ws + WS_PARTK); bf16_t* mvb = (bf16_t*)(ws + WS_MVB); float* mvo = out + O_MVP;
#pragma unroll
        for (int ai = 0; ai < 2; ++ai)
#pragma unroll
            for (int m = 0; m < 4; ++m) { const int r = rbase + ai * 128 + m * 16; const float rs = rsv[ai][m]; float ss = 0.f;
#pragma unroll
                for (int bj = 0; bj < 2; ++bj) { const af4 a = acc[ai][bj][m][0] * rs, b = acc[ai][bj][m][1] * rs; const size_t o = (size_t)r * 512 + colS + bj * 32;
                    if (pn < 2) { ss += (a[0] * a[0] + a[1] * a[1]) + (a[2] * a[2] + a[3] * a[3]) + (b[0] * b[0] + b[1] * b[1]) + (b[2] * b[2] + b[3] * b[3]); *(af4*)(mk + o) = a; *(af4*)(mk + o + 4) = b; }
                    else { *(af4*)(mvo + o) = a; *(af4*)(mvo + o + 4) = b; u32x4 w; w.x = pk2(a[0], a[1]); w.y = pk2(a[2], a[3]); w.z = pk2(b[0], b[1]); w.w = pk2(b[2], b[3]); *(u32x4*)(mvb + o) = w; } }
                if (pn < 2) { ss += __shfl_xor(ss, 16); ss += __shfl_xor(ss, 32); if (fq == 0) part[(size_t)r * 8 + (pn & 1) * 4 + wc] = ss; } }
    }
    __device__ __forceinline__ void operator()(EPI_ARGS) const {
        const int pn = u.pn, pm = u.pm;
        const int rbase = pm * 256 + wr * 64 + fr;
        if (pn >= 26) { mkv(acc, u, wr, wc, fr, fq); return; }
        float rsv[2][4];
#pragma unroll
        for (int ai = 0; ai < 2; ++ai)
#pragma unroll
            for (int m = 0; m < 4; ++m) rsv[ai][m] = rstd[rbase + ai * 128 + m * 16];
        if (pn >= 14) {
            bf16_t* G = (bf16_t*)(ws + WS_GT);
            const int col0 = (pn - 14) * 256 + wc * 32 + 8 * fq;
#pragma unroll
            for (int ai = 0; ai < 2; ++ai)
#pragma unroll
                for (int m = 0; m < 4; ++m) { const int r = rbase + ai * 128 + m * 16; const float rs = rsv[ai][m]; bf16_t* rowp = G + (size_t)r * 3072 + col0;
#pragma unroll
                    for (int bj = 0; bj < 2; ++bj) { const af4 v0 = acc[ai][bj][m][0] * rs, v1 = acc[ai][bj][m][1] * rs; u32x4 w;
                        w.x = pk2(fast_sigmoid(v0[0]), fast_sigmoid(v0[1])); w.y = pk2(fast_sigmoid(v0[2]), fast_sigmoid(v0[3]));
                        w.z = pk2(fast_sigmoid(v1[0]), fast_sigmoid(v1[1])); w.w = pk2(fast_sigmoid(v1[2]), fast_sigmoid(v1[3]));
                        *(u32x4*)(rowp + bj * 128) = w; } }
            return;
        }
        const int sec = pn >> 1;
        const int colS = (pn & 1) * 256 + wc * 64 + 8 * fq;
        if (sec == 6) {
            bf16_t* Q = (bf16_t*)(ws + WS_QM); float* part = (float*)(ws + WS_PARTQ);
            const float qs = 0.08838834764831845f * LOG2E;
            const int dd0 = (wc & 1) * 64 + 8 * fq;
            af4 g[2][2];
#pragma unroll
            for (int bj = 0; bj < 2; ++bj)
#pragma unroll
                for (int n = 0; n < 2; ++n) g[bj][n] = *(const af4*)(g_qm + dd0 + 32 * bj + 4 * n) * qs;
#pragma unroll
            for (int ai = 0; ai < 2; ++ai)
#pragma unroll
                for (int m = 0; m < 4; ++m) { const int r = rbase + ai * 128 + m * 16; const float rs = rsv[ai][m]; float ss = 0.f; bf16_t* rowp = Q + (size_t)r * 512 + colS;
#pragma unroll
                    for (int bj = 0; bj < 2; ++bj) { const af4 v0 = acc[ai][bj][m][0] * rs, v1 = acc[ai][bj][m][1] * rs;
                        ss += (v0[0] * v0[0] + v0[1] * v0[1]) + (v0[2] * v0[2] + v0[3] * v0[3]) + (v1[0] * v1[0] + v1[1] * v1[1]) + (v1[2] * v1[2] + v1[3] * v1[3]);
                        const af4 a = v0 * g[bj][0], b = v1 * g[bj][1]; u32x4 w; w.x = pk2(a[0], a[1]); w.y = pk2(a[2], a[3]); w.z = pk2(b[0], b[1]); w.w = pk2(b[2], b[3]);
                        *(u32x4*)(rowp + bj * 32) = w; }
                    ss += __shfl_xor(ss, 16); ss += __shfl_xor(ss, 32);
                    if (fq == 0) part[(size_t)r * 8 + (pn & 1) * 4 + wc] = ss; }
            return;
        }
        const bool normed = (sec == 0 || sec == 1 || sec == 3 || sec == 4);
        const bool isq = (sec == 0 || sec == 3);
        const float *gA = opq(g_qa), *gB = opq(g_ka), *gC = opq(g_qb), *gD = opq(g_kb);
        const float* gp = sec == 0 ? gA : sec == 1 ? gB : sec == 3 ? gC : gD;
        bf16_t* B = (bf16_t*)(ws + (sec == 0 ? WS_QA : sec == 1 ? WS_KA : sec == 2 ? WS_VA : sec == 3 ? WS_QB : sec == 4 ? WS_KB : WS_VB));
        af4 g[2][2];
#pragma unroll
        for (int bj = 0; bj < 2; ++bj)
#pragma unroll
            for (int n = 0; n < 2; ++n) g[bj][n] = normed ? *(const af4*)(gp + 8 * fq + 32 * bj + 4 * n) * (isq ? 0.125f * LOG2E : 1.0f) : (af4){1.f, 1.f, 1.f, 1.f};
        float* fo = nullptr; long frow_off = 0;
        const bool sample = pm >= 64;
        if (sec == 1 || sec == 2) {
            if (sample) { fo = out + (sec == 1 ? O_AKS : O_AVS); frow_off = -(long)MP; }
            else if ((pm & 15) >= 14) { fo = out + (sec == 1 ? O_AKP : O_AVP); frow_off = -(long)((pm >> 4) * 4096 + 3584) + (long)(pm >> 4) * 512; }
        } else if (sec == 4 || sec == 5) {
            if (sample) { fo = out + (sec == 4 ? O_BKS : O_BVS); frow_off = -(long)MP; } else { fo = out + (sec == 4 ? O_BKP : O_BVP); frow_off = 0; }
        }
#pragma unroll
        for (int ai = 0; ai < 2; ++ai)
#pragma unroll
            for (int m = 0; m < 4; ++m) { const int r = rbase + ai * 128 + m * 16; const float rs = rsv[ai][m];
                af4 v[2][2]; float ss = 0.f;
#pragma unroll
                for (int bj = 0; bj < 2; ++bj)
#pragma unroll
                    for (int n = 0; n < 2; ++n) { v[bj][n] = acc[ai][bj][m][n] * rs; const af4 t = v[bj][n]; ss += (t[0] * t[0] + t[1] * t[1]) + (t[2] * t[2] + t[3] * t[3]); }
                float rn = 1.0f;
                if (normed) { ss += __shfl_xor(ss, 16); ss += __shfl_xor(ss, 32); rn = 1.0f / sqrtf(ss * (1.0f / 64.0f) + EPS); }
                bf16_t* rowp = B + (size_t)r * 512 + colS;
#pragma unroll
                for (int bj = 0; bj < 2; ++bj) { const af4 a = v[bj][0] * rn * g[bj][0], b = v[bj][1] * rn * g[bj][1];
                    u32x4 w; w.x = pk2(a[0], a[1]); w.y = pk2(a[2], a[3]); w.z = pk2(b[0], b[1]); w.w = pk2(b[2], b[3]);
                    *(u32x4*)(rowp + bj * 32) = w;
                    if (fo) { float* fp = fo + (size_t)((long)r + frow_off) * 512 + colS + bj * 32; *(af4*)fp = a; *(af4*)(fp + 4) = b; } } }
    }
};

#ifndef HOOKF
#define HOOKF 3
#endif
struct EpiMergeH {
    static constexpr bool PERM = true, AFTER_DRAIN = false, MID = true;
    unsigned char* ws;
    static __device__ __forceinline__ void unpack8(const u32x4 gw, af4& a, af4& b) {
        a[0] = __uint_as_float(gw.x << 16); a[1] = __uint_as_float(gw.x & 0xffff0000u); a[2] = __uint_as_float(gw.y << 16); a[3] = __uint_as_float(gw.y & 0xffff0000u);
        b[0] = __uint_as_float(gw.z << 16); b[1] = __uint_as_float(gw.z & 0xffff0000u); b[2] = __uint_as_float(gw.w << 16); b[3] = __uint_as_float(gw.w & 0xffff0000u);
#pragma unroll
        for (int i = 0; i < 4; ++i) { a[i] = fmaxf(a[i], 1e-20f); b[i] = fmaxf(b[i], 1e-20f); }
    }
    static __device__ __forceinline__ void unpack8raw(const u32x4 gw, af4& a, af4& b) {
        a[0] = __uint_as_float(gw.x << 16); a[1] = __uint_as_float(gw.x & 0xffff0000u); a[2] = __uint_as_float(gw.y << 16); a[3] = __uint_as_float(gw.y & 0xffff0000u);
        b[0] = __uint_as_float(gw.z << 16); b[1] = __uint_as_float(gw.z & 0xffff0000u); b[2] = __uint_as_float(gw.w << 16); b[3] = __uint_as_float(gw.w & 0xffff0000u);
    }
    __device__ __forceinline__ void mid(af4 (&acc)[2][2][4][2], const pg8::Unit& u, int t, int wr, int wc, int fr, int fq) const {
        const bf16_t* G = (const bf16_t*)(ws + WS_GT) + (t == 8 ? 0 : 1024);
        int rbase = u.pm * 256 + wr * 64 + fr; const int col0 = u.pn * 256 + wc * 32 + 8 * fq;
        asm volatile("" : "+v"(rbase));
#pragma unroll
        for (int ai = 0; ai < 2; ++ai)
#pragma unroll
            for (int m = 0; m < 4; ++m) { const int r = rbase + ai * 128 + m * 16;
#pragma unroll
                for (int bj = 0; bj < 2; ++bj) { const bf16_t* gp = G + (unsigned)(r * 3072 + col0 + bj * 128); af4 na, nb, da, db; unpack8(*(const u32x4*)gp, na, nb); unpack8(*(const u32x4*)(gp + 1024), da, db);
#pragma unroll
                    for (int i = 0; i < 4; ++i) { acc[ai][bj][m][0][i] *= na[i] * __builtin_amdgcn_rcpf(da[i]); acc[ai][bj][m][1][i] *= nb[i] * __builtin_amdgcn_rcpf(db[i]); } }
                if ((m & HOOKF) == HOOKF) asm volatile("" ::: "memory"); }
    }
    __device__ __forceinline__ void operator()(EPI_ARGS) const {
        const bf16_t* G = (const bf16_t*)(ws + WS_GT) + 2048; bf16_t* H = (bf16_t*)(ws + WS_H);
        const int rbase = u.pm * 256 + wr * 64 + fr; const int col0 = u.pn * 256 + wc * 32 + 8 * fq;
#pragma unroll
        for (int ai = 0; ai < 2; ++ai) {
            u32x4 gv[4][2];
#pragma unroll
            for (int m = 0; m < 4; ++m)
#pragma unroll
                for (int bj = 0; bj < 2; ++bj) gv[m][bj] = *(const u32x4*)(G + (unsigned)((rbase + ai * 128 + m * 16) * 3072 + col0 + bj * 128));
#pragma unroll
            for (int m = 0; m < 4; ++m) { const int r = rbase + ai * 128 + m * 16;
#pragma unroll
                for (int bj = 0; bj < 2; ++bj) { const int c = col0 + bj * 128; af4 ga, gb; unpack8(gv[m][bj], ga, gb);
                    const af4 a = acc[ai][bj][m][0] * ga, b = acc[ai][bj][m][1] * gb;
                    u32x4 w; w.x = pk2(a[0], a[1]); w.y = pk2(a[2], a[3]); w.z = pk2(b[0], b[1]); w.w = pk2(b[2], b[3]); *(u32x4*)(H + (size_t)r * 1024 + c) = w; } }
            asm volatile("" ::: "memory");
        }
    }
};

struct EpiWo {
    static constexpr bool PERM = true, AFTER_DRAIN = false, MID = false;
    const float* xp; const float* xs; float* out; bf16_t* X1B; float* ssq;
    __device__ __forceinline__ void operator()(EPI_ARGS) const {
        const int rbase = u.pm * 256 + wr * 64 + fr; const int col0 = u.pn * 256 + wc * 32 + 8 * fq;
        const float *xA = opq(xs), *xB = opq(xp);
        const float* xin = u.pm >= 64 ? xA - (size_t)MP * 1024 : xB;
#pragma unroll
        for (int ai = 0; ai < 2; ++ai) {
            af4 xv[4][2][2];
#pragma unroll
            for (int m = 0; m < 4; ++m)
#pragma unroll
                for (int bj = 0; bj < 2; ++bj) { const size_t o = (size_t)(rbase + ai * 128 + m * 16) * 1024 + col0 + bj * 128; xv[m][bj][0] = *(const af4*)(xin + o); xv[m][bj][1] = *(const af4*)(xin + o + 4); }
#pragma unroll
            for (int m = 0; m < 4; ++m) { const int r = rbase + ai * 128 + m * 16; float ss = 0.f;
#pragma unroll
                for (int bj = 0; bj < 2; ++bj) { const size_t o = (size_t)r * 1024 + col0 + bj * 128;
                    const af4 a = acc[ai][bj][m][0] + xv[m][bj][0], b = acc[ai][bj][m][1] + xv[m][bj][1];
                    ss += (a[0] * a[0] + a[1] * a[1]) + (a[2] * a[2] + a[3] * a[3]) + (b[0] * b[0] + b[1] * b[1]) + (b[2] * b[2] + b[3] * b[3]);
                    u32x4 w; w.x = pk2(a[0], a[1]); w.y = pk2(a[2], a[3]); w.z = pk2(b[0], b[1]); w.w = pk2(b[2], b[3]); *(u32x4*)(X1B + o) = w; }
                ss += __shfl_xor(ss, 16); ss += __shfl_xor(ss, 32);
                if (fq == 0) unsafeAtomicAdd(ssq + r, ss); }
            asm volatile("" ::: "memory");
        }
    }
};

struct EpiUp {
    static constexpr bool PERM = true, AFTER_DRAIN = false, MID = false;
    unsigned char* ws;
    __device__ __forceinline__ void operator()(EPI_ARGS) const {
        bf16_t* HF = (bf16_t*)(ws + WS_HF); const float* ssq = (const float*)(ws + WS_SSQ2);
        const int rbase = u.pm * 256 + wr * 64 + fr; const int col0 = u.pn * 256 + wc * 32 + 8 * fq;
        float sq[2][4];
#pragma unroll
        for (int ai = 0; ai < 2; ++ai)
#pragma unroll
            for (int m = 0; m < 4; ++m) sq[ai][m] = ssq[rbase + ai * 128 + m * 16];
#pragma unroll
        for (int ai = 0; ai < 2; ++ai)
#pragma unroll
            for (int m = 0; m < 4; ++m) { const int r = rbase + ai * 128 + m * 16; const float rs = 1.0f / sqrtf(sq[ai][m] * (1.0f / 1024.0f) + EPS);
#pragma unroll
                for (int bj = 0; bj < 2; ++bj) { af4 a = acc[ai][bj][m][0] * rs, b = acc[ai][bj][m][1] * rs;
#pragma unroll
                    for (int i = 0; i < 4; ++i) { a[i] = fmaxf(a[i], 0.f); a[i] *= a[i]; b[i] = fmaxf(b[i], 0.f); b[i] *= b[i]; }
                    u32x4 w; w.x = pk2(a[0], a[1]); w.y = pk2(a[2], a[3]); w.z = pk2(b[0], b[1]); w.w = pk2(b[2], b[3]);
                    *(u32x4*)(HF + (size_t)r * 4096 + col0 + bj * 128) = w; } }
    }
};

struct EpiDown {
    static constexpr bool PERM = true, AFTER_DRAIN = false, MID = false;
    float* out; const bf16_t* X1B;
    __device__ __forceinline__ void operator()(EPI_ARGS) const {
        const int rbase = u.pm * 256 + wr * 64 + fr; const int col0 = u.pn * 256 + wc * 32 + 8 * fq;
#pragma unroll
        for (int ai = 0; ai < 2; ++ai) {
            u32x4 xv[4][2];
#pragma unroll
            for (int m = 0; m < 4; ++m)
#pragma unroll
                for (int bj = 0; bj < 2; ++bj) xv[m][bj] = *(const u32x4*)(X1B + (size_t)(rbase + ai * 128 + m * 16) * 1024 + col0 + bj * 128);
#pragma unroll
            for (int m = 0; m < 4; ++m) { const int r = rbase + ai * 128 + m * 16;
#pragma unroll
                for (int bj = 0; bj < 2; ++bj) { float* p = out + (size_t)r * 1024 + col0 + bj * 128; af4 xa, xb; EpiMergeH::unpack8raw(xv[m][bj], xa, xb);
                    const af4 a = acc[ai][bj][m][0] + xa, b = acc[ai][bj][m][1] + xb; *(af4*)p = a; *(af4*)(p + 4) = b; } }
            asm volatile("" ::: "memory");
        }
    }
};

enum { A_BANDP = 0, A_FORGETP = 1, A_MEMP = 2, A_BANDS = 3, A_FORGETS = 4, A_MEMS = 5 };
#define LDS_BAR() do { asm volatile("s_waitcnt lgkmcnt(0)" ::: "memory"); __builtin_amdgcn_s_barrier(); asm volatile("" ::: "memory"); } while (0)
#define MFMA32(a, b, c) __builtin_amdgcn_mfma_f32_32x32x16_bf16((a), (b), (c), 0, 0, 0)
typedef short v4i16_t __attribute__((ext_vector_type(4)));
__device__ __forceinline__ s16x4 tr_read(const LAS char* p) { return __builtin_bit_cast(s16x4, __builtin_amdgcn_ds_read_tr16_b64_v4i16((LAS v4i16_t*)p)); }
constexpr int ATT_TB_OFF = 96 * 1024, ATT_ITEM_OFF = ATT_TB_OFF + 2048;
constexpr float NEGBIG = -1e30f;

struct AttnCtx {
    const float* const* in;
    float* out; unsigned char* ws;
};
template <int D> struct TileRegs { u32x4 k[2]; u32x4 v[2]; float kb; };
template <int D, int MODE> struct PKof { static constexpr int PK = D * 2 + 16 + ((MODE == A_FORGETP || MODE == A_FORGETS) ? 32 : 0); };
#ifndef FP_KT
#define FP_KT 128
#endif
template <int D, int MODE> struct KTof { static constexpr int KT = D == 128 ? 32 : (MODE == A_FORGETP ? FP_KT : 64), TPR = 512 / KT, CPT = D * KT / 512; };
template <int MODE> __device__ __forceinline__ bool tile_is_f32(int j) {
    return MODE == A_MEMS || (MODE == A_BANDS && j < 8) || (MODE == A_FORGETS && j < 32);
}
__device__ __forceinline__ u32x4 ld16(const void* p) { return *(const u32x4*)p; }

template <int D, int MODE> __device__ __forceinline__ void tile_issue(TileRegs<D>& T, const Args& A, const unsigned char* ws, int j, int b, int h, int tid) {
    constexpr int KT = KTof<D, MODE>::KT, TPR = KTof<D, MODE>::TPR, CPT = KTof<D, MODE>::CPT;
    const int row = tid / TPR, cgp = tid % TPR;
    const int hcol = h * D + cgp * CPT;
    const u32x4 z = {0u, 0u, 0u, 0u};
#pragma unroll
    for (int i = 0; i < 2; ++i) { T.k[i] = z; T.v[i] = z; }
    T.kb = 0.f;
    if (MODE == A_BANDP || MODE == A_FORGETP) {
        const size_t o = (size_t)(b * SEQ + KT * j + row) * 512 + hcol;
        const bf16_t* kp = (const bf16_t*)(ws + (MODE == A_BANDP ? WS_KA : WS_KB)) + o; const bf16_t* vp = (const bf16_t*)(ws + (MODE == A_BANDP ? WS_VA : WS_VB)) + o;
#pragma unroll
        for (int i = 0; i < CPT / 8; ++i) { T.k[i] = ld16(kp + 8 * i); T.v[i] = ld16(vp + 8 * i); }
        if (MODE == A_FORGETP && cgp == 0) T.kb = ((const float*)(ws + WS_CP))[(size_t)(b * 8 + h) * SEQ + KT * j + row];
    } else if (MODE == A_MEMP) {
        const size_t o = (size_t)(b * NMEM + KT * j + row) * 512 + hcol;
        const float* kp = (const float*)(ws + WS_MKRAW) + o; const bf16_t* vp = (const bf16_t*)(ws + WS_MVB) + o;
#pragma unroll
        for (int i = 0; i < 2; ++i) T.k[i] = ld16(kp + 4 * i);
        T.v[0] = ld16(vp);
        const float* pk = (const float*)(ws + WS_PARTK) + (size_t)(b * NMEM + KT * j + row) * 8 + h * 2;
        T.kb = 1.0f / sqrtf((pk[0] + pk[1]) * (1.0f / 128.0f) + EPS);
    } else if (tile_is_f32<MODE>(j)) {
        const float *ksrc, *vsrc; size_t o;
        if (MODE == A_BANDS) { ksrc = A.in[3]; vsrc = A.in[4]; o = (size_t)(b * ACACHE + KT * j + row) * 512 + hcol; }
        else if (MODE == A_FORGETS) { ksrc = A.in[5]; vsrc = A.in[6]; o = (size_t)(b * PAST + KT * j + row) * 512 + hcol; }
        else { ksrc = A.in[8]; vsrc = A.in[9]; o = (size_t)(b * NMEM + KT * j + row) * 512 + hcol; }
#pragma unroll
        for (int i = 0; i < 2; ++i) { T.k[i] = ld16(ksrc + o + 4 * i); T.v[i] = ld16(vsrc + o + 4 * i); }
        if (MODE == A_FORGETS && cgp == 0) T.kb = ((const float*)(ws + WS_CS))[(size_t)(b * 8 + h) * SLEN + KT * j + row];
    } else {
        if (row < SSEQ) {
            const size_t o = (size_t)(MP + b * SSEQ + row) * 512 + hcol;
            const bf16_t* kp = (const bf16_t*)(ws + (MODE == A_BANDS ? WS_KA : WS_KB)) + o; const bf16_t* vp = (const bf16_t*)(ws + (MODE == A_BANDS ? WS_VA : WS_VB)) + o;
            T.k[0] = ld16(kp); T.v[0] = ld16(vp);
            if (MODE == A_FORGETS && cgp == 0) T.kb = ((const float*)(ws + WS_CS))[(size_t)(b * 8 + h) * SLEN + PAST + row];
        }
    }
}
__device__ __forceinline__ u32x4 cvt8(const u32x4 a, const u32x4 b) {
    u32x4 w; w.x = pk2(__uint_as_float(a.x), __uint_as_float(a.y)); w.y = pk2(__uint_as_float(a.z), __uint_as_float(a.w));
    w.z = pk2(__uint_as_float(b.x), __uint_as_float(b.y)); w.w = pk2(__uint_as_float(b.z), __uint_as_float(b.w)); return w;
}
template <int D, int MODE> __device__ __forceinline__ void tile_store(TileRegs<D>& T, LAS char* buf, const Args& A, float* out, int j, int b, int h, int tid, float cref, bool emit) {
    constexpr int PK = PKof<D, MODE>::PK, KT = KTof<D, MODE>::KT, TPR = KTof<D, MODE>::TPR, CPT = KTof<D, MODE>::CPT;
    const int row = tid / TPR, cgp = tid % TPR;
    LAS char* kd = buf + row * PK + cgp * CPT * 2; LAS char* vd = buf + KT * PK + row * (D * 2 + 16) + cgp * CPT * 2;
    if (MODE == A_MEMP) {
        const float* g = A.in[18] + cgp * 8; const float rk = T.kb;
#pragma unroll
        for (int i = 0; i < 2; ++i) { const f32x4 gv = *(const f32x4*)(g + 4 * i); f32x4 x = __builtin_bit_cast(f32x4, T.k[i]); x = x * rk * gv; T.k[i] = __builtin_bit_cast(u32x4, x); }
        if (emit) { float* o = out + O_MKP + (size_t)(b * NMEM + KT * j + row) * 512 + h * D + cgp * 8;
#pragma unroll
            for (int i = 0; i < 2; ++i) *(u32x4*)(o + 4 * i) = T.k[i]; }
        { *(LAS u32x4*)kd = cvt8(T.k[0], T.k[1]); *(LAS u32x4*)vd = T.v[0]; }
    } else if (tile_is_f32<MODE>(j)) {
        { *(LAS u32x4*)kd = cvt8(T.k[0], T.k[1]); *(LAS u32x4*)vd = cvt8(T.v[0], T.v[1]); }
    } else {
        {
#pragma unroll
            for (int i = 0; i < CPT / 8; ++i) { *(LAS u32x4*)(kd + 16 * i) = T.k[i]; *(LAS u32x4*)(vd + 16 * i) = T.v[i]; } }
    }
    if ((MODE == A_FORGETP || MODE == A_FORGETS) && cgp == 0) {
        const float kb = cref - T.kb; const unsigned h0 = f2bf(kb); const float r1 = kb - __uint_as_float(h0 << 16); const unsigned h1 = f2bf(r1); const float r2 = r1 - __uint_as_float(h1 << 16); const unsigned h2 = f2bf(r2);
        const u32x4 w0 = {h0 | (h1 << 16), h2, 0u, 0u}, w1 = {0u, 0u, 0u, 0u};
        *(LAS u32x4*)(buf + row * PK + D * 2) = w0; *(LAS u32x4*)(buf + row * PK + D * 2 + 16) = w1; }
}

template <int D, int NH, int PK>
__device__ __forceinline__ void softmax_pv(f32x16 (&p)[NH], const LAS char* Vl, f32x16 (&O)[D / 32 + 1], float& m_run, float& l_run, bool first, int lane) {
    const int hh = lane >> 5;
    float mt = p[0][0];
#pragma unroll
    for (int i = 1; i < 16; ++i) mt = fmaxf(mt, p[0][i]);
#pragma unroll
    for (int half = 1; half < NH; ++half)
#pragma unroll
        for (int i = 0; i < 16; ++i) mt = fmaxf(mt, p[half][i]);
    mt = fmaxf(mt, __shfl_xor(mt, 32));
    if (first || __any(mt > 0.f)) {
        const float dl = first ? mt : fmaxf(mt, 0.f); const float alpha = first ? 0.f : __builtin_amdgcn_exp2f(-dl);
        m_run += dl;
#pragma unroll
        for (int half = 0; half < NH; ++half) p[half] = p[half] - dl;
#pragma unroll
        for (int d = 0; d <= D / 32; ++d) O[d] = O[d] * alpha;
    }
#pragma unroll
    for (int half = 0; half < NH; ++half)
#pragma unroll
        for (int i = 0; i < 16; ++i) p[half][i] = __builtin_amdgcn_exp2f(p[half][i]);
    bf16x8 vones;
#pragma unroll
    for (int j = 0; j < 8; ++j) vones[j] = (lane & 31) == 0 ? (short)0x3F80 : (short)0;
    const int q4 = (lane & 15) >> 2, p3 = lane & 3, blk = (lane >> 4) & 1;
#pragma unroll
    for (int half = 0; half < NH; ++half)
#pragma unroll
        for (int s2 = 0; s2 < 2; ++s2) {
            u32x4 pw; pw.x = pk2(p[half][8 * s2], p[half][8 * s2 + 1]); pw.y = pk2(p[half][8 * s2 + 2], p[half][8 * s2 + 3]);
            pw.z = pk2(p[half][8 * s2 + 4], p[half][8 * s2 + 5]); pw.w = pk2(p[half][8 * s2 + 6], p[half][8 * s2 + 7]);
            const bf16x8 pf = __builtin_bit_cast(bf16x8, pw);
#pragma unroll
            for (int d = 0; d < D / 32; ++d) {
                const LAS char* vp = Vl + (32 * half + 16 * s2 + 4 * hh + q4) * PK + d * 64 + blk * 32 + p3 * 8;
                const s16x4 lo = tr_read(vp), hi = tr_read(vp + 8 * PK);
                const bf16x8 vf = __builtin_shufflevector(lo, hi, 0, 1, 2, 3, 4, 5, 6, 7);
                O[d] = MFMA32(vf, pf, O[d]);
            }
            O[D / 32] = MFMA32(vones, pf, O[D / 32]);
        }
}

template <int D, int MODE>
__device__ __forceinline__ void compute_tile(const LAS char* buf, const bf16x8 (&qf)[D / 16], f32x16 (&O)[D / 32 + 1], float& m_run, float& l_run, bool first,
                                             int lane, int qpos, int qpos_min, int kpos0, bool diag, int nvalid, const LAS float* tb, float rq) {
    constexpr int PK = PKof<D, MODE>::PK, KT = KTof<D, MODE>::KT, NH = KT / 32;
    const int r = lane & 31, hh = lane >> 5;
    const LAS char* Kl = buf; const LAS char* Vl = buf + KT * PK;
    f32x16 p[NH];
    constexpr bool BAND = (MODE == A_BANDP || MODE == A_BANDS), FORGET = (MODE == A_FORGETP || MODE == A_FORGETS), MEM = (MODE == A_MEMP || MODE == A_MEMS);
    const bool far = BAND && (qpos_min - (kpos0 + KT - 1) >= 128);
    const float c0 = MEM ? 0.f : (far ? tb[256] : 0.f) - m_run;
#pragma unroll
    for (int half = 0; half < NH; ++half)
#pragma unroll
        for (int i = 0; i < 16; ++i) p[half][i] = c0;
    if (FORGET) {
        bf16x8 qone;
#pragma unroll
        for (int j = 0; j < 8; ++j) qone[j] = (hh == 0 && j < 3) ? (short)0x3F80 : (short)0;
#pragma unroll
        for (int half = 0; half < NH; ++half) { const bf16x8 kf = *(const LAS bf16x8*)(Kl + (32 * half + r) * PK + D * 2 + 16 * hh); p[half] = MFMA32(kf, qone, p[half]); }
    }
#pragma unroll
    for (int half = 0; half < NH; ++half)
#pragma unroll
        for (int s = 0; s < D / 16; ++s) { const bf16x8 kf = *(const LAS bf16x8*)(Kl + (32 * half + r) * PK + (16 * s + 8 * hh) * 2); p[half] = MFMA32(kf, qf[s], p[half]); }
    if (MEM) {
#pragma unroll
        for (int half = 0; half < NH; ++half) p[half] = p[half] * rq - m_run;
    }
    if (BAND && !far) {
#pragma unroll
        for (int half = 0; half < NH; ++half)
#pragma unroll
            for (int i = 0; i < 16; ++i) { const int kv = kpos0 + 32 * half + (i & 3) + 8 * (i >> 2) + 4 * hh; int dist = qpos - kv; dist = dist < -128 ? -128 : dist; dist = dist > 128 ? 128 : dist; p[half][i] += tb[dist + 128]; }
    }
    if (FORGET && diag) {
#pragma unroll
        for (int half = 0; half < NH; ++half)
#pragma unroll
            for (int i = 0; i < 16; ++i) { const int kv = kpos0 + 32 * half + (i & 3) + 8 * (i >> 2) + 4 * hh; if (kv > qpos) p[half][i] = NEGBIG; }
    }
    if (MODE == A_BANDS && nvalid < KT) {
#pragma unroll
        for (int half = 0; half < NH; ++half)
#pragma unroll
            for (int i = 0; i < 16; ++i) { const int kl = 32 * half + (i & 3) + 8 * (i >> 2) + 4 * hh; if (kl >= nvalid) p[half][i] = NEGBIG; }
    }
    softmax_pv<D, NH, D * 2 + 16>(p, Vl, O, m_run, l_run, first, lane);
}

template <int D, int MODE>
__device__ __forceinline__ void attn_unit(const Args& A, float* out, unsigned char* ws, LAS char* lds, int b, int h, int qb) {
    constexpr int PK = PKof<D, MODE>::PK, KT = KTof<D, MODE>::KT, BUFSZ = KT * PK + KT * (D * 2 + 16) + 256;
    constexpr bool BAND = (MODE == A_BANDP || MODE == A_BANDS), FORGET = (MODE == A_FORGETP || MODE == A_FORGETS), MEM = (MODE == A_MEMP || MODE == A_MEMS);
    constexpr bool SAMPLE = (MODE >= A_BANDS);
    static_assert(2 * BUFSZ <= ATT_TB_OFF, "attention LDS");
    const int tid = threadIdx.x, lane = tid & 63, r = lane & 31, hh = lane >> 5; const int wid = __builtin_amdgcn_readfirstlane(tid >> 6);
    LAS float* tb = (LAS float*)(lds + ATT_TB_OFF);
    int j0 = 0, j1 = 0, qpos = 0, qpos_min = 0, qrow = 0, jlo = 0, jhi = 0;
    if (MODE == A_BANDP) { const int c = 4 * qb + (wid >> 1); qpos_min = c * 64 + (wid & 1) * 32; qpos = qpos_min + r; qrow = b * SEQ + qpos; j0 = 4 * qb - 8 < 0 ? 0 : 4 * qb - 8; j1 = 4 * qb + 3; jlo = c - 8; jhi = c; }
    else if (MODE == A_FORGETP) { qpos_min = qb * 256 + 32 * wid; qpos = qpos_min + r; qrow = b * SEQ + qpos; j0 = 0; j1 = (qb * 256 + 255) / KT; jlo = 0; jhi = qpos_min / KT; }
    else if (MODE == A_MEMP) { qrow = b * SEQ + qb * 256 + 32 * wid + r; j0 = 0; j1 = NMEM / KT - 1; jlo = 0; jhi = j1; }
    else { qpos_min = PAST; qpos = PAST + (r & 15); qrow = MP + b * SSEQ + (r & 15); j0 = 0; j1 = MODE == A_BANDS ? 8 : MODE == A_FORGETS ? 32 : NMEM / KT - 1; jlo = 0; jhi = wid == 0 ? j1 : -1; }
    if (BAND && tid < 257) tb[tid] = A.in[19][tid * 8 + h] * LOG2E;
    const bf16_t* Qb = (const bf16_t*)(ws + (BAND ? WS_QA : FORGET ? WS_QB : WS_QM));
    bf16x8 qf[D / 16];
#pragma unroll
    for (int s = 0; s < D / 16; ++s) qf[s] = *(const bf16x8*)(Qb + (size_t)qrow * 512 + h * D + 16 * s + 8 * hh);
    float rq = 1.f;
    if (MEM) { const float* pq = (const float*)(ws + WS_PARTQ) + (size_t)qrow * 8 + h * 2; rq = 1.0f / sqrtf((pq[0] + pq[1]) * (1.0f / 128.0f) + EPS); }
    float cref = 0.f;
    if (MODE == A_FORGETP) cref = ((const float*)(ws + WS_CP))[(size_t)(b * 8 + h) * SEQ + qb * 256];
    if (MODE == A_FORGETS) cref = ((const float*)(ws + WS_CS))[(size_t)(b * 8 + h) * SLEN + PAST];
    f32x16 O[D / 32 + 1];
#pragma unroll
    for (int d = 0; d <= D / 32; ++d)
#pragma unroll
        for (int i = 0; i < 16; ++i) O[d][i] = 0.f;
    float m_run = 0.f, l_run = 0.f; bool first = true;
    TileRegs<D> T;
    const int jstart = FORGET ? j1 : j0, jend = FORGET ? j0 : j1, jstep = FORGET ? -1 : 1;
    tile_issue<D, MODE>(T, A, ws, jstart, b, h, tid);
    for (int j = jstart, n = 0;; j += jstep, ++n) {
        LAS char* buf = lds + (n & 1) * BUFSZ;
        tile_store<D, MODE>(T, buf, A, out, j, b, h, tid, cref, qb == 0);
        if (j != jend) tile_issue<D, MODE>(T, A, ws, j + jstep, b, h, tid);
        LDS_BAR();
        if (j >= jlo && j <= jhi) {
            int kpos0 = KT * j, nvalid = KT; bool diag = false;
            if (MODE == A_BANDS) { kpos0 = PAST - ACACHE + 64 * j; if (j == 8) nvalid = SSEQ; }
            if (MODE == A_FORGETP) diag = (j == jhi);
            if (MODE == A_FORGETS) diag = (j == 32);
            compute_tile<D, MODE>(buf, qf, O, m_run, l_run, first, lane, qpos, qpos_min, kpos0, diag, nvalid, tb, rq);
            first = false;
        }
        if (j == jend) break;
    }
    const float l = __shfl(O[D / 32][0], lane & 31); const float inv = 1.0f / l;
    bf16_t* Ob = (bf16_t*)(ws + WS_OC) + (size_t)qrow * 1536 + (BAND ? 0 : FORGET ? 512 : 1024) + h * D;
    if (!SAMPLE || (wid == 0 && r < SSEQ)) {
#pragma unroll
        for (int d = 0; d < D / 32; ++d)
#pragma unroll
            for (int i4 = 0; i4 < 4; ++i4) { u32x2 w; w.x = pk2(O[d][4 * i4] * inv, O[d][4 * i4 + 1] * inv); w.y = pk2(O[d][4 * i4 + 2] * inv, O[d][4 * i4 + 3] * inv);
                *(u32x2*)(Ob + d * 32 + 8 * i4 + 4 * hh) = w; }
    }
    LDS_BAR();
}


__device__ __forceinline__ bf16x8 cvt8f(const f32x4 a, const f32x4 b) { u32x4 w; w.x = pk2(a[0], a[1]); w.y = pk2(a[2], a[3]); w.z = pk2(b[0], b[1]); w.w = pk2(b[2], b[3]); return __builtin_bit_cast(bf16x8, w); }
template <int D> struct STile { f32x4 k[D / 8]; f32x4 v[D / 8]; float cs; };
template <int D, int MODE> __device__ __forceinline__ void stile_load(STile<D>& S, const float* kc, const float* vc, const float* csp, int t, int lane) {
    const int r = lane & 31, hh = lane >> 5;
    const float* kp = kc + (size_t)(32 * t + r) * 512 + 8 * hh;
#pragma unroll
    for (int s = 0; s < D / 16; ++s) { S.k[2 * s] = *(const f32x4*)(kp + 16 * s); S.k[2 * s + 1] = *(const f32x4*)(kp + 16 * s + 4); }
    const float* vp = vc + (size_t)(32 * t + (lane >> 1)) * 512 + (lane & 1) * (D / 2);
#pragma unroll
    for (int i = 0; i < D / 8; ++i) S.v[i] = *(const f32x4*)(vp + 4 * i);
    S.cs = (MODE == A_FORGETS) ? csp[32 * t + r] : 0.f;
}
template <int D, int MODE>
__device__ __forceinline__ void stile_compute(const bf16x8 (&kf)[D / 16], float kbias, LAS char* Vw, const bf16x8 (&qf)[D / 16], f32x16 (&O)[D / 32 + 1], float& m_run, float& l_run, bool first,
                                              int lane, int qpos, int kpos0, bool lastnew, const LAS float* tb, float rq) {
    constexpr int PV = D * 2 + 16;
    constexpr bool BAND = (MODE == A_BANDS), FORGET = (MODE == A_FORGETS), MEM = (MODE == A_MEMS);
    const int hh = lane >> 5;
    const bool far = BAND && (PAST - (kpos0 + 31) >= 128);
    f32x16 p[1];
    const float c0 = MEM ? 0.f : (far ? tb[256] : 0.f) - m_run;
#pragma unroll
    for (int i = 0; i < 16; ++i) p[0][i] = c0;
    if (FORGET) {
        const unsigned h0 = f2bf(kbias); const float r1 = kbias - __uint_as_float(h0 << 16); const unsigned h1 = f2bf(r1); const float r2 = r1 - __uint_as_float(h1 << 16); const unsigned h2 = f2bf(r2);
        u32x4 kw = {h0 | (h1 << 16), h2, 0u, 0u}; if (hh) kw = (u32x4){0u, 0u, 0u, 0u};
        bf16x8 qone;
#pragma unroll
        for (int j = 0; j < 8; ++j) qone[j] = (hh == 0 && j < 3) ? (short)0x3F80 : (short)0;
        p[0] = MFMA32(__builtin_bit_cast(bf16x8, kw), qone, p[0]);
    }
#pragma unroll
    for (int s = 0; s < D / 16; ++s) p[0] = MFMA32(kf[s], qf[s], p[0]);
    if (MEM) p[0] = p[0] * rq - m_run;
    if (BAND && !far) {
#pragma unroll
        for (int i = 0; i < 16; ++i) { const int kl = (i & 3) + 8 * (i >> 2) + 4 * hh; int dist = qpos - (kpos0 + kl); dist = dist < -128 ? -128 : dist; dist = dist > 128 ? 128 : dist; p[0][i] += tb[dist + 128]; if (lastnew && kl >= SSEQ) p[0][i] = NEGBIG; }
    }
    if (FORGET && lastnew) {
#pragma unroll
        for (int i = 0; i < 16; ++i) { const int kl = (i & 3) + 8 * (i >> 2) + 4 * hh; if (kpos0 + kl > qpos) p[0][i] = NEGBIG; }
    }
    softmax_pv<D, 1, PV>(p, Vw, O, m_run, l_run, first, lane);
}
template <int D, int MODE>
__device__ __forceinline__ void attn_unit_sample(const Args& A, unsigned char* ws, LAS char* lds, int b, int h) {
    constexpr int PV = D * 2 + 16;
    constexpr bool BAND = (MODE == A_BANDS), FORGET = (MODE == A_FORGETS), MEM = (MODE == A_MEMS);
    static_assert(8 * 32 * PV <= ATT_TB_OFF && (256 + 8 * D * 16) * 4 <= ATT_TB_OFF, "sample attention LDS");
    const int tid = threadIdx.x, lane = tid & 63, r = lane & 31, hh = lane >> 5; const int wid = __builtin_amdgcn_readfirstlane(tid >> 6);
    LAS char* Vw = lds + wid * (32 * PV);
    LAS float* tb = (LAS float*)(lds + ATT_TB_OFF);
    constexpr int NCACHE = BAND ? ACACHE : FORGET ? PAST : NMEM, NTC = NCACHE / 32;
    const float* kc = (BAND ? A.in[3] : FORGET ? A.in[5] : A.in[8]) + (size_t)b * NCACHE * 512 + h * D;
    const float* vc = (BAND ? A.in[4] : FORGET ? A.in[6] : A.in[9]) + (size_t)b * NCACHE * 512 + h * D;
    const float* csp = (const float*)(ws + WS_CS) + (size_t)(b * 8 + h) * SLEN;
    const int qrow = MP + b * SSEQ + (r & 15), qpos = PAST + (r & 15);
    if (BAND) { if (tid < 257) tb[tid] = A.in[19][tid * 8 + h] * LOG2E; LDS_BAR(); }
    const bf16_t* Qb = (const bf16_t*)(ws + (BAND ? WS_QA : FORGET ? WS_QB : WS_QM));
    bf16x8 qf[D / 16];
#pragma unroll
    for (int s = 0; s < D / 16; ++s) qf[s] = *(const bf16x8*)(Qb + (size_t)qrow * 512 + h * D + 16 * s + 8 * hh);
    float rq = 1.f;
    if (MEM) { const float* pq = (const float*)(ws + WS_PARTQ) + (size_t)qrow * 8 + h * 2; rq = 1.0f / sqrtf((pq[0] + pq[1]) * (1.0f / 128.0f) + EPS); }
    const float cref = FORGET ? csp[PAST] : 0.f;
    f32x16 O[D / 32 + 1];
#pragma unroll
    for (int d = 0; d <= D / 32; ++d)
#pragma unroll
        for (int i = 0; i < 16; ++i) O[d][i] = 0.f;
    float m_run = 0.f, l_run = 0.f; bool first = true;
    const int kbase = BAND ? PAST - ACACHE : 0;
    STile<D> S;
    stile_load<D, MODE>(S, kc, vc, csp, wid, lane);
    for (int t = wid; t < NTC; t += 8) {
        bf16x8 kf[D / 16];
#pragma unroll
        for (int s = 0; s < D / 16; ++s) kf[s] = cvt8f(S.k[2 * s], S.k[2 * s + 1]);
        { LAS char* vd = Vw + (lane >> 1) * PV + (lane & 1) * D;
#pragma unroll
          for (int i = 0; i < D / 16; ++i) *(LAS bf16x8*)(vd + 16 * i) = cvt8f(S.v[2 * i], S.v[2 * i + 1]); }
        const float kb = cref - S.cs;
        if (D == 64 && t + 8 < NTC) stile_load<D, MODE>(S, kc, vc, csp, t + 8, lane);
        asm volatile("s_waitcnt lgkmcnt(0)" ::: "memory");
        stile_compute<D, MODE>(kf, kb, Vw, qf, O, m_run, l_run, first, lane, qpos, kbase + 32 * t, false, tb, rq);
        first = false;
        asm volatile("s_waitcnt lgkmcnt(0)" ::: "memory");
    }
    if (!MEM && wid == 0) {
        const bf16_t* kn = (const bf16_t*)(ws + (BAND ? WS_KA : WS_KB)) + (size_t)(MP + b * SSEQ) * 512 + h * D;
        const bf16_t* vn = (const bf16_t*)(ws + (BAND ? WS_VA : WS_VB)) + (size_t)(MP + b * SSEQ) * 512 + h * D;
        bf16x8 kf[D / 16]; const bf16x8 z8 = {0, 0, 0, 0, 0, 0, 0, 0};
#pragma unroll
        for (int s = 0; s < D / 16; ++s) kf[s] = r < SSEQ ? *(const bf16x8*)(kn + (size_t)r * 512 + 16 * s + 8 * hh) : z8;
        { const int row = lane >> 1; LAS char* vd = Vw + row * PV + (lane & 1) * D;
#pragma unroll
          for (int i = 0; i < D / 16; ++i) *(LAS bf16x8*)(vd + 16 * i) = row < SSEQ ? *(const bf16x8*)(vn + (size_t)row * 512 + (lane & 1) * (D / 2) + 8 * i) : z8; }
        const float kb = cref - ((FORGET && r < SSEQ) ? csp[PAST + r] : 0.f);
        asm volatile("s_waitcnt lgkmcnt(0)" ::: "memory");
        stile_compute<D, MODE>(kf, kb, Vw, qf, O, m_run, l_run, first, lane, qpos, PAST, true, tb, rq);
        asm volatile("s_waitcnt lgkmcnt(0)" ::: "memory");
    }
    const float l_tot = __shfl(O[D / 32][0], lane & 31);
    LDS_BAR();
    LAS float* Mw = (LAS float*)lds; LAS float* Lw = Mw + 128; LAS float* Ow = Mw + 256;
    if (r < SSEQ) {
        if (hh == 0) { Mw[wid * 16 + r] = m_run; Lw[wid * 16 + r] = l_tot; }
#pragma unroll
        for (int d = 0; d < D / 32; ++d)
#pragma unroll
            for (int i = 0; i < 16; ++i) Ow[(wid * D + d * 32 + (i & 3) + 8 * (i >> 2) + 4 * hh) * 16 + r] = O[d][i];
    }
    LDS_BAR();
    { const int q = tid & 15, dg = tid >> 4; float M = Mw[q];
#pragma unroll
      for (int w = 1; w < 8; ++w) M = fmaxf(M, Mw[w * 16 + q]);
      float sc[8], L = 0.f;
#pragma unroll
      for (int w = 0; w < 8; ++w) { sc[w] = __builtin_amdgcn_exp2f(Mw[w * 16 + q] - M); L += Lw[w * 16 + q] * sc[w]; }
      const float inv = 1.0f / L; float o[D / 32];
#pragma unroll
      for (int e = 0; e < D / 32; ++e) { const int d = dg * (D / 32) + e; float a = 0.f;
#pragma unroll
          for (int w = 0; w < 8; ++w) a += Ow[(w * D + d) * 16 + q] * sc[w];
          o[e] = a * inv; }
      bf16_t* Ob = (bf16_t*)(ws + WS_OC) + (size_t)(MP + b * SSEQ + q) * 1536 + (BAND ? 0 : FORGET ? 512 : 1024) + h * D + dg * (D / 32);
      if (D == 64) *(unsigned*)Ob = pk2(o[0], o[1]); else { u32x2 w2; w2.x = pk2(o[0], o[1]); w2.y = pk2(o[D / 32 - 2], o[D / 32 - 1]); *(u32x2*)Ob = w2; } }
    LDS_BAR();
}

constexpr int Q_FP = 512, Q_FS = Q_FP + 256, Q_BP = Q_FS + 512, Q_MP = Q_BP + 256, Q_BS = Q_MP + 256, Q_MS = Q_BS + 128;
__device__ __forceinline__ int queue_next(unsigned* ctr, LAS int* itemw) {
    if (threadIdx.x == 0) *itemw = (int)atomicAdd(ctr, 1u);
    LDS_BAR();
    const int it = __builtin_amdgcn_readfirstlane(*itemw);
    LDS_BAR();
    return it;
}
#ifndef ATTMASK
#define ATTMASK 63
#endif
#ifndef P2MASK
#define P2MASK 63
#endif
#define AM(k) (((ATTMASK >> (k)) & 1) && (pass == 0 || ((P2MASK >> (k)) & 1)))
__device__ __forceinline__ void attention_phase(const Args& A, float* out, unsigned char* ws, LAS char* lds, int pass) {
    unsigned* ctr = (unsigned*)(ws + WS_CTL) + pass;
    LAS int* itemw = (LAS int*)(lds + ATT_ITEM_OFF);
    int it = queue_next(ctr, itemw);
    while (it < 768) { const int g = it / 3, k = it % 3;
        if (k == 2) { if (AM(4)) attn_unit_sample<64, A_FORGETS>(A, ws, lds, g >> 3, g & 7); }
        else if (AM(1)) { const int idx = 2 * g + k; attn_unit<64, A_FORGETP>(A, out, ws, lds, (idx & 31) >> 3, idx & 7, 15 - (idx >> 5)); }
        it = queue_next(ctr, itemw); }
    while (it < 1536) { const int i = it - 768; const int g = i / 3, k = i % 3;
        if (k == 2) { if (AM(3)) attn_unit_sample<64, A_BANDS>(A, ws, lds, g >> 3, g & 7); }
        else if (AM(0)) { const int idx = 2 * g + k; attn_unit<64, A_BANDP>(A, out, ws, lds, (idx & 31) >> 3, idx & 7, idx >> 5); }
        it = queue_next(ctr, itemw); }
    while (it < 1920) { const int i = it - 1536;
        if (i >= 256) { const int g = i - 256; if (AM(5)) attn_unit_sample<128, A_MEMS>(A, ws, lds, g >> 2, g & 3); }
        else if (AM(2)) { const int idx = i; attn_unit<128, A_MEMP>(A, out, ws, lds, (idx & 15) >> 2, idx & 3, idx >> 4); }
        it = queue_next(ctr, itemw); }
}

__device__ __forceinline__ void transpose_item(const float* W, int ldw, int K, int src_col0, bf16_t* WT, int dst_row0, const float* g, LAS float* scr, int kb, int lane) {
    const int k0 = 64 * kb;
    float wv[32];
#pragma unroll
    for (int i = 0; i < 32; ++i) { const int kk = 2 * i + (lane >> 5); wv[i] = W[(size_t)(k0 + kk) * ldw + src_col0 + (lane & 31)]; }
    if (g) {
#pragma unroll
        for (int i = 0; i < 32; ++i) wv[i] *= g[k0 + 2 * i + (lane >> 5)];
    }
#pragma unroll
    for (int i = 0; i < 32; ++i) scr[(2 * i + (lane >> 5)) * 33 + (lane & 31)] = wv[i];
    asm volatile("s_waitcnt lgkmcnt(0)" ::: "memory");
    const int c = lane & 7;
#pragma unroll
    for (int j = 0; j < 4; ++j) { const int n = (lane >> 3) + 8 * j; const LAS float* s = scr + (8 * c) * 33 + n;
        u32x4 o; o.x = pk2(s[0 * 33], s[1 * 33]); o.y = pk2(s[2 * 33], s[3 * 33]); o.z = pk2(s[4 * 33], s[5 * 33]); o.w = pk2(s[6 * 33], s[7 * 33]);
        *(u32x4*)(WT + (size_t)(dst_row0 + n) * K + k0 + 8 * c) = o; }
    asm volatile("s_waitcnt lgkmcnt(0)" ::: "memory");
}
__device__ __forceinline__ int perm_src_blk(int wb) { const int bj = wb >> 2, wc = wb & 3; return 2 * wc + bj; }

__device__ __forceinline__ void prologue(const Args& A, float* out, unsigned char* ws, LAS char* lds) {
    const int tid = threadIdx.x, lane = tid & 63; const int wave = __builtin_amdgcn_readfirstlane(tid >> 6);
    const int gw = blockIdx.x * 8 + wave, NGW = gridDim.x * 8;
    const float *xpp = opq(A.in[0]), *xsp = opq(A.in[1]), *memp = opq(A.in[2]);
    if (blockIdx.x == 0 && tid < 64) ((unsigned*)(ws + WS_CTL))[tid] = 0u;
    { float* ssq = (float*)(ws + WS_SSQ2); for (int i = blockIdx.x * 512 + tid; i < MT; i += gridDim.x * 512) ssq[i] = 0.f; }
    LAS float* wfl = (LAS float*)(lds + 8 * 8448);
    for (int k = tid; k < 1024; k += 512) { const float* wp = A.in[11] + (size_t)k * DIN + 3072; const f32x4 a = *(const f32x4*)wp, b = *(const f32x4*)(wp + 4); const float g = A.in[10][k];
#pragma unroll
        for (int c = 0; c < 4; ++c) { wfl[c * 1024 + k] = a[c] * g; wfl[(c + 4) * 1024 + k] = b[c] * g; } }
    LAS float* scr = (LAS float*)(lds + wave * 8448);
    constexpr int I_IN = 208 * 16, I_MKV = 32 * 16;
    constexpr int NITEMS = I_IN + I_MKV;
    for (int it = gw; it < NITEMS; it += NGW) {
        int r = it;
        if (r < I_IN) { const int db = r >> 4, kb = r & 15, tile = db >> 3, wb = db & 7; int src;
            if (tile < 14) { const int sec = tile >> 1; const int secstart = sec < 6 ? sec * 512 : 3080; src = secstart + (tile & 1) * 256 + perm_src_blk(wb) * 32; }
            else src = 3592 + (tile - 14) * 256 + wb * 32;
            transpose_item(A.in[11], DIN, 1024, src, (bf16_t*)(ws + WS_WIN), db * 32, A.in[10], scr, kb, lane); continue; }
        r -= I_IN;
        { const int db = r >> 4, kb = r & 15, tile = db >> 3, wb = db & 7;
            transpose_item(A.in[21], 1024, 1024, tile * 256 + perm_src_blk(wb) * 32, (bf16_t*)(ws + WS_WMKV), db * 32, A.in[20], scr, kb, lane); }
    }
    LDS_BAR();
#define XROW_PTR(m_) ((m_) >= MT ? memp + (size_t)((m_) - MT) * 1024 : ((m_) < MP ? xpp + (size_t)(m_) * 1024 : xsp + (size_t)((m_) - MP) * 1024))
    f32x4 nx[4];
    if (gw < MT + 1024) { const f32x4* xr = (const f32x4*)XROW_PTR(gw) + lane;
#pragma unroll
        for (int j = 0; j < 4; ++j) nx[j] = xr[64 * j]; }
    for (int m = gw; m < MT + 1024; m += NGW) {
        const bool ismem = m >= MT;
        bf16_t* orow = ismem ? (bf16_t*)(ws + WS_MB) + (size_t)(m - MT) * 1024 : (bf16_t*)(ws + WS_XB) + (size_t)m * 1024;
        f32x4 v[4]; float ss = 0.f;
#pragma unroll
        for (int j = 0; j < 4; ++j) v[j] = nx[j];
        if (m + NGW < MT + 1024) { const f32x4* xr = (const f32x4*)XROW_PTR(m + NGW) + lane;
#pragma unroll
            for (int j = 0; j < 4; ++j) nx[j] = xr[64 * j]; }
#pragma unroll
        for (int j = 0; j < 4; ++j) ss += (v[j][0] * v[j][0] + v[j][1] * v[j][1]) + (v[j][2] * v[j][2] + v[j][3] * v[j][3]);
        const float rstd = 1.0f / sqrtf(wave_sum(ss) * (1.0f / 1024.0f) + EPS);
        u32x2* o8 = (u32x2*)orow + lane;
#pragma unroll
        for (int j = 0; j < 4; ++j) { u32x2 w; w.x = pk2(v[j][0], v[j][1]); w.y = pk2(v[j][2], v[j][3]); o8[64 * j] = w; }
        if (ismem) { if (lane == 0) ((float*)(ws + WS_RSTDM))[m - MT] = rstd; continue; }
        if (lane == 0) ((float*)(ws + WS_RSTD1))[m] = rstd;
        float d[8];
#pragma unroll
        for (int c = 0; c < 8; ++c) d[c] = 0.f;
#pragma unroll
        for (int j = 0; j < 4; ++j)
#pragma unroll
            for (int c = 0; c < 8; ++c) { const f32x4 w = *(const LAS f32x4*)(wfl + c * 1024 + 4 * (lane + 64 * j)); d[c] += (v[j][0] * w[0] + v[j][1] * w[1]) + (v[j][2] * w[2] + v[j][3] * w[3]); }
        float mine = 0.f;
#pragma unroll
        for (int c = 0; c < 8; ++c) { const float s = wave_sum(d[c]); if (lane == c) mine = s; }
        if (lane < 8) { const float z = mine * rstd + A.in[12][lane]; const float lf = fminf(z, 0.f) - log1pf(expf(-fabsf(z)));
            if (m < MP) out[O_LFP + (size_t)m * 8 + lane] = lf; else out[O_LFS + (size_t)(m - MP) * 8 + lane] = lf; }
    }
}


__device__ __forceinline__ void late_weights(const Args& A, unsigned char* ws, LAS char* lds, int gw, int NGW) {
    const int lane = threadIdx.x & 63; const int wave = __builtin_amdgcn_readfirstlane(threadIdx.x >> 6);
    LAS float* scr = (LAS float*)(lds + wave * 8448);
    const float *wpa = opq(A.in[22]), *wpb = opq(A.in[23]), *wpm = opq(A.in[24]);
    constexpr int I_P = 32 * 8, I_O = 32 * 16, I_UP = 128 * 16, I_DN = 32 * 64;
    constexpr int NITEMS = 3 * I_P + I_O + I_UP + I_DN;
    for (int it = gw; it < NITEMS; it += NGW) {
        int r = it;
        if (r < 3 * I_P) { const int w = r / I_P, q = r % I_P; const int db = q >> 3, kb = q & 7;
            transpose_item(w == 0 ? wpa : w == 1 ? wpb : wpm, 1024, 1536, db * 32, (bf16_t*)(ws + WS_WPC) + w * 512, db * 32, nullptr, scr, kb, lane); continue; }
        r -= 3 * I_P;
        if (r < I_O) { const int db = r >> 4, kb = r & 15; transpose_item(A.in[25], 1024, 1024, db * 32, (bf16_t*)(ws + WS_WO), db * 32, nullptr, scr, kb, lane); continue; }
        r -= I_O;
        if (r < I_UP) { const int db = r >> 4, kb = r & 15; transpose_item(A.in[27], 4096, 1024, db * 32, (bf16_t*)(ws + WS_WUP), db * 32, A.in[26], scr, kb, lane); continue; }
        r -= I_UP;
        { const int db = r >> 6, kb = r & 63; transpose_item(A.in[28], 1024, 4096, db * 32, (bf16_t*)(ws + WS_WDN), db * 32, nullptr, scr, kb, lane); }
    }
}

__device__ __forceinline__ void cumsum_seq(const Args& A, const float* out, unsigned char* ws, int seq, int lane) {
    const bool prompt = seq < 32; const int bh = prompt ? seq : seq - 32; const int b = bh >> 3, h = bh & 7;
    const int n = prompt ? SEQ : SLEN; const int per = (n + 63) / 64; const int start = lane * per;
    float* dst = prompt ? (float*)(ws + WS_CP) + (size_t)bh * SEQ : (float*)(ws + WS_CS) + (size_t)bh * SLEN;
    const float* clf = A.in[7];
#define CS_GET(i) (prompt ? out[O_LFP + ((size_t)b * SEQ + (i)) * 8 + h] : ((i) < PAST ? clf[((size_t)b * PAST + (i)) * 8 + h] : out[O_LFS + ((size_t)b * SSEQ + ((i) - PAST)) * 8 + h]))
    float s = 0.f;
    for (int i = 0; i < per; ++i) { const int idx = start + i; if (idx < n) s += CS_GET(idx); }
    float incl = s;
#pragma unroll
    for (int o = 1; o < 64; o <<= 1) { const float t = __shfl_up(incl, o); if (lane >= o) incl += t; }
    float run = incl - s;
    for (int i = 0; i < per; ++i) { const int idx = start + i; if (idx < n) { run += CS_GET(idx); dst[idx] = run * LOG2E; } }
}


template <int K, int LDA, int LDB> __device__ __forceinline__ f32x4 sg_tile(const bf16_t* Arow0, const bf16_t* Bcol0, LAS float* red) {
    const int tid = threadIdx.x, lane = tid & 63, r = lane & 31, hh = lane >> 5; const int wid = __builtin_amdgcn_readfirstlane(tid >> 6);
    constexpr int KW = K / 8, NS = KW / 16, UN = NS >= 8 ? 4 : NS / 2;
    static_assert(NS % (2 * UN) == 0, "sg_tile K");
    const bf16_t* ap = Arow0 + (size_t)r * LDA + wid * KW + 8 * hh;
    const bf16_t* b0 = Bcol0 + (size_t)r * LDB + wid * KW + 8 * hh;
    const bf16_t* b1 = b0 + (size_t)32 * LDB;
    f32x16 c0, c1;
#pragma unroll
    for (int i = 0; i < 16; ++i) { c0[i] = 0.f; c1[i] = 0.f; }
    bf16x8 fa[UN], fb0[UN], fb1[UN], ga[UN], gb0[UN], gb1[UN];
#pragma unroll
    for (int i = 0; i < UN; ++i) { fa[i] = *(const bf16x8*)(ap + i * 16); fb0[i] = *(const bf16x8*)(b0 + i * 16); fb1[i] = *(const bf16x8*)(b1 + i * 16); }
    for (int s0 = 0; s0 < NS; s0 += 2 * UN) {
#pragma unroll
        for (int i = 0; i < UN; ++i) { ga[i] = *(const bf16x8*)(ap + (s0 + UN + i) * 16); gb0[i] = *(const bf16x8*)(b0 + (s0 + UN + i) * 16); gb1[i] = *(const bf16x8*)(b1 + (s0 + UN + i) * 16); }
#pragma unroll
        for (int i = 0; i < UN; ++i) { c0 = MFMA32(fa[i], fb0[i], c0); c1 = MFMA32(fa[i], fb1[i], c1); }
        if (s0 + 2 * UN < NS) {
#pragma unroll
            for (int i = 0; i < UN; ++i) { fa[i] = *(const bf16x8*)(ap + (s0 + 2 * UN + i) * 16); fb0[i] = *(const bf16x8*)(b0 + (s0 + 2 * UN + i) * 16); fb1[i] = *(const bf16x8*)(b1 + (s0 + 2 * UN + i) * 16); }
        }
#pragma unroll
        for (int i = 0; i < UN; ++i) { c0 = MFMA32(ga[i], gb0[i], c0); c1 = MFMA32(ga[i], gb1[i], c1); }
    }
#pragma unroll
    for (int i = 0; i < 16; ++i) { const int row = (i & 3) + 8 * (i >> 2) + 4 * hh; red[(wid * 32 + row) * 64 + r] = c0[i]; red[(wid * 32 + row) * 64 + 32 + r] = c1[i]; }
    LDS_BAR();
    const int row = tid >> 4, c4 = (tid & 15) * 4;
    f32x4 v = *(const LAS f32x4*)(red + row * 64 + c4);
#pragma unroll
    for (int w = 1; w < 8; ++w) v += *(const LAS f32x4*)(red + (w * 32 + row) * 64 + c4);
    LDS_BAR();
    return v;
}
template <int K, int LDA, int LDB> __device__ __forceinline__ void sg_tile2(const bf16_t* Arow0, const bf16_t* Bcol0, LAS float* red, f32x4 (&v)[2]) {
    const int tid = threadIdx.x, lane = tid & 63, r = lane & 31, hh = lane >> 5; const int wid = __builtin_amdgcn_readfirstlane(tid >> 6);
    constexpr int KW = K / 8, NS = KW / 16, UN = NS >= 8 ? 4 : NS / 2;
    static_assert(NS % (2 * UN) == 0, "sg_tile2 K");
    const bf16_t* a0 = Arow0 + (size_t)r * LDA + wid * KW + 8 * hh;
    const bf16_t* a1 = a0 + (size_t)32 * LDA;
    const bf16_t* b0 = Bcol0 + (size_t)r * LDB + wid * KW + 8 * hh;
    const bf16_t* b1 = b0 + (size_t)32 * LDB;
    f32x16 c[2][2];
#pragma unroll
    for (int i = 0; i < 16; ++i) { c[0][0][i] = 0.f; c[0][1][i] = 0.f; c[1][0][i] = 0.f; c[1][1][i] = 0.f; }
    bf16x8 fa0[UN], fa1[UN], fb0[UN], fb1[UN], ga0[UN], ga1[UN], gb0[UN], gb1[UN];
#pragma unroll
    for (int i = 0; i < UN; ++i) { fa0[i] = *(const bf16x8*)(a0 + i * 16); fa1[i] = *(const bf16x8*)(a1 + i * 16); fb0[i] = *(const bf16x8*)(b0 + i * 16); fb1[i] = *(const bf16x8*)(b1 + i * 16); }
    for (int s0 = 0; s0 < NS; s0 += 2 * UN) {
#pragma unroll
        for (int i = 0; i < UN; ++i) { const int o = (s0 + UN + i) * 16; ga0[i] = *(const bf16x8*)(a0 + o); ga1[i] = *(const bf16x8*)(a1 + o); gb0[i] = *(const bf16x8*)(b0 + o); gb1[i] = *(const bf16x8*)(b1 + o); }
#pragma unroll
        for (int i = 0; i < UN; ++i) { c[0][0] = MFMA32(fa0[i], fb0[i], c[0][0]); c[0][1] = MFMA32(fa0[i], fb1[i], c[0][1]); c[1][0] = MFMA32(fa1[i], fb0[i], c[1][0]); c[1][1] = MFMA32(fa1[i], fb1[i], c[1][1]); }
        if (s0 + 2 * UN < NS) {
#pragma unroll
            for (int i = 0; i < UN; ++i) { const int o = (s0 + 2 * UN + i) * 16; fa0[i] = *(const bf16x8*)(a0 + o); fa1[i] = *(const bf16x8*)(a1 + o); fb0[i] = *(const bf16x8*)(b0 + o); fb1[i] = *(const bf16x8*)(b1 + o); }
        }
#pragma unroll
        for (int i = 0; i < UN; ++i) { c[0][0] = MFMA32(ga0[i], gb0[i], c[0][0]); c[0][1] = MFMA32(ga0[i], gb1[i], c[0][1]); c[1][0] = MFMA32(ga1[i], gb0[i], c[1][0]); c[1][1] = MFMA32(ga1[i], gb1[i], c[1][1]); }
    }
    const int row = tid >> 4, c4 = (tid & 15) * 4;
#pragma unroll
    for (int h = 0; h < 2; ++h) {
#pragma unroll
        for (int i = 0; i < 16; ++i) { const int rr = (i & 3) + 8 * (i >> 2) + 4 * hh; red[(wid * 32 + rr) * 64 + r] = c[h][0][i]; red[(wid * 32 + rr) * 64 + 32 + r] = c[h][1][i]; }
        LDS_BAR();
        f32x4 s = *(const LAS f32x4*)(red + row * 64 + c4);
#pragma unroll
        for (int w = 1; w < 8; ++w) s += *(const LAS f32x4*)(red + (w * 32 + row) * 64 + c4);
        v[h] = s;
        LDS_BAR();
    }
}
__device__ __forceinline__ f32x4 bf4_to_f32(u32x2 w) { f32x4 g; g[0] = __uint_as_float(w.x << 16); g[1] = __uint_as_float(w.x & 0xffff0000u); g[2] = __uint_as_float(w.y << 16); g[3] = __uint_as_float(w.y & 0xffff0000u); return g; }
__device__ __forceinline__ u32x2 f32_to_bf4(f32x4 v) { u32x2 w; w.x = pk2(v[0], v[1]); w.y = pk2(v[2], v[3]); return w; }
__device__ __forceinline__ void sample_merge(unsigned char* ws, LAS float* red, int t) {
    const int rt = t >> 4, ct = t & 15; const int row = MP + rt * 32 + (threadIdx.x >> 4), col = ct * 64 + (threadIdx.x & 15) * 4;
    const bf16_t* G = (const bf16_t*)(ws + WS_GT) + (size_t)row * 3072 + col;
    const bf16_t* oc = (const bf16_t*)(ws + WS_OC) + (size_t)(MP + rt * 32) * 1536; const bf16_t* wp = (const bf16_t*)(ws + WS_WPC) + (size_t)ct * 64 * 1536;
    f32x4 h = sg_tile<512, 1536, 1536>(oc, wp, red) * bf4_to_f32(*(const u32x2*)G);
    h += sg_tile<512, 1536, 1536>(oc + 512, wp + 512, red) * bf4_to_f32(*(const u32x2*)(G + 1024));
    h += sg_tile<512, 1536, 1536>(oc + 1024, wp + 1024, red) * bf4_to_f32(*(const u32x2*)(G + 2048));
    *(u32x2*)((bf16_t*)(ws + WS_H) + (size_t)row * 1024 + col) = f32_to_bf4(h);
}
__device__ __forceinline__ void sample_wo(const float* xs, float* out, unsigned char* ws, LAS float* red, int t) {
    const int rt = t >> 4, ct = t & 15; const int row = MP + rt * 32 + (threadIdx.x >> 4), col = ct * 64 + (threadIdx.x & 15) * 4;
    f32x4 v = sg_tile<1024, 1024, 1024>((const bf16_t*)(ws + WS_H) + (size_t)(MP + rt * 32) * 1024, (const bf16_t*)(ws + WS_WO) + (size_t)ct * 64 * 1024, red);
    v += *(const f32x4*)(xs + (size_t)(row - MP) * 1024 + col);
    *(u32x2*)((bf16_t*)(ws + WS_X1B) + (size_t)row * 1024 + col) = f32_to_bf4(v);
    float ss = (v[0] * v[0] + v[1] * v[1]) + (v[2] * v[2] + v[3] * v[3]);
    ss += __shfl_xor(ss, 1); ss += __shfl_xor(ss, 2); ss += __shfl_xor(ss, 4); ss += __shfl_xor(ss, 8);
    if ((threadIdx.x & 15) == 0) unsafeAtomicAdd((float*)(ws + WS_SSQ2) + row, ss);
}
__device__ __forceinline__ void sample_up(unsigned char* ws, LAS float* red, int p) {
    const int rp = p >> 6, ct = p & 63; const int col = ct * 64 + (threadIdx.x & 15) * 4;
    f32x4 v[2];
    sg_tile2<1024, 1024, 1024>((const bf16_t*)(ws + WS_X1B) + (size_t)(MP + rp * 64) * 1024, (const bf16_t*)(ws + WS_WUP) + (size_t)ct * 64 * 1024, red, v);
#pragma unroll
    for (int h = 0; h < 2; ++h) { const int row = MP + rp * 64 + h * 32 + (threadIdx.x >> 4);
        const float rs = 1.0f / sqrtf(((const float*)(ws + WS_SSQ2))[row] * (1.0f / 1024.0f) + EPS); f32x4 x = v[h];
#pragma unroll
        for (int i = 0; i < 4; ++i) { float a = fmaxf(x[i] * rs, 0.f); x[i] = a * a; }
        *(u32x2*)((bf16_t*)(ws + WS_HF) + (size_t)row * 4096 + col) = f32_to_bf4(x); }
}
__device__ __forceinline__ void sample_down(float* out, unsigned char* ws, LAS float* red, int t) {
    const int rt = t >> 4, ct = t & 15; const int row = MP + rt * 32 + (threadIdx.x >> 4), col = ct * 64 + (threadIdx.x & 15) * 4;
    f32x4 v = sg_tile<4096, 4096, 4096>((const bf16_t*)(ws + WS_HF) + (size_t)(MP + rt * 32) * 4096, (const bf16_t*)(ws + WS_WDN) + (size_t)ct * 64 * 4096, red);
    *(f32x4*)(out + (size_t)row * 1024 + col) = v + bf4_to_f32(*(const u32x2*)((const bf16_t*)(ws + WS_X1B) + (size_t)row * 1024 + col));
}
struct SchedIn {
    pg8::StaticOrder so;
    __device__ bool next(int i, pg8::Unit& u) const {
        const long L = (long)i * so.G + so.c;
        if (L < so.nwg) return so.next(i, u);
        const int e = (int)(L - so.nwg); if (e >= 16) return false;
        u.pm = MT / 256 + (e >> 2); u.pn = NIN / 256 + (e & 3); return true;
    }
    __device__ __forceinline__ void a_ready(const pg8::Unit&) const {}
    __device__ __forceinline__ void done(const pg8::Unit&) const {}
};

#define XB_TMO      128
#define XB_XCNT(j)  (256  + 64 * (j))
#define XB_XSUB(j)  (1280 + 64 * (j))
#define XB_XGEN(j)  (2304 + 64 * (j))
#define XB_TOP      3328
#define XB_TOPGEN   3392
#define XCD_BAR_WORDS 3456
#define XB_SPIN_CAP (1u << 18)

__device__ __forceinline__ unsigned xb_ld(unsigned* p)              { return __hip_atomic_load(p, __ATOMIC_RELAXED, __HIP_MEMORY_SCOPE_AGENT); }
__device__ __forceinline__ unsigned xb_add(unsigned* p, unsigned v) { return __hip_atomic_fetch_add(p, v, __ATOMIC_RELAXED, __HIP_MEMORY_SCOPE_AGENT); }
__device__ __forceinline__ unsigned xb_xcc_id() { return (unsigned)__builtin_amdgcn_s_getreg((3 << 11) | 20) & 0xFu; }
#define XB_SPIN(cond, bar) do { unsigned _sp = 0; while (cond) { __builtin_amdgcn_s_sleep(1); \
    if ((++_sp & 255u) == 0u) { if (xb_ld(&(bar)[XB_TMO])) break; if (_sp > XB_SPIN_CAP) { atomicAdd(&(bar)[XB_TMO], 1u); break; } } } } while (0)

struct XcdBarrier {
    unsigned* bar; unsigned x;
    volatile LAS unsigned* st;
};

__device__ __forceinline__ XcdBarrier xcd_barrier_post(unsigned* bar, volatile LAS unsigned* st) {
    XcdBarrier b; b.bar = bar; b.x = xb_xcc_id(); b.st = st;
    if (threadIdx.x == 0) (void)xb_add(&bar[XB_XCNT(b.x)], 1u);
    return b;
}
__device__ __forceinline__ void xcd_barrier_complete(unsigned* bar, unsigned x, unsigned& nloc, unsigned& nx) {
    const unsigned G = gridDim.x * gridDim.y * gridDim.z;
    unsigned sum, cnt, mine, sp = 0u;
    for (;;) {
        sum = 0u; cnt = 0u; mine = 0u;
#pragma unroll
        for (unsigned j = 0; j < 16; ++j) { const unsigned c = xb_ld(&bar[XB_XCNT(j)]); sum += c; cnt += (c > 0u) ? 1u : 0u; mine = (j == x) ? c : mine; }
        if (sum == G) break;
        __builtin_amdgcn_s_sleep(1);
        if ((++sp & 255u) == 0u) { if (xb_ld(&bar[XB_TMO])) break; if (sp > XB_SPIN_CAP) { atomicAdd(&bar[XB_TMO], 1u); break; } }
    }
    nloc = mine > 0u ? mine : 1u; nx = cnt > 0u ? cnt : 1u;
}

__device__ __forceinline__ void xcd_barrier(const XcdBarrier& b) {
    asm volatile("s_waitcnt vmcnt(0)" ::: "memory");
    __syncthreads();
    if (threadIdx.x == 0) {
        unsigned* bar = b.bar;
        __builtin_amdgcn_s_waitcnt(0);
        unsigned nloc = b.st[0], nx = b.st[1];
        if (nloc == 0u) { xcd_barrier_complete(bar, b.x, nloc, nx); b.st[0] = nloc; b.st[1] = nx; }
        const unsigned old = xb_add(&bar[XB_XSUB(b.x)], 1u);
        const unsigned gen = old / nloc;
        if (old + 1u == (gen + 1u) * nloc) {
            __builtin_amdgcn_fence(__ATOMIC_RELEASE, "agent");
            asm volatile("s_waitcnt vmcnt(0)" ::: "memory");
            const unsigned og = xb_add(&bar[XB_TOP], 1u);
            const unsigned tg = og / nx;
            if (og + 1u == (tg + 1u) * nx) xb_add(&bar[XB_TOPGEN], 1u);
            else XB_SPIN(xb_ld(&bar[XB_TOPGEN]) == tg, bar);
            __builtin_amdgcn_fence(__ATOMIC_ACQUIRE, "agent");
            xb_add(&bar[XB_XGEN(b.x)], 1u);
            asm volatile("s_waitcnt vmcnt(0)" ::: "memory");
        } else {
            XB_SPIN(xb_ld(&bar[XB_XGEN(b.x)]) == gen, bar);
            __builtin_amdgcn_fence(__ATOMIC_ACQUIRE, "agent");
            asm volatile("s_waitcnt vmcnt(0)" ::: "memory");
        }
    }
    __syncthreads();
}

constexpr int LDS_BYTES = 131072 + 1024;
__global__ void __launch_bounds__(512, 2) mega_fwd(Args args) {
    extern __shared__ __attribute__((aligned(16))) unsigned char lds_raw[];
    cg::grid_group grid = cg::this_grid();
    LAS unsigned char* lds = (LAS unsigned char*)lds_raw;
    const Args& A = args; float* out = args.out; unsigned char* ws = args.ws;
    const int lo = args.ph_lo, hi = args.ph_hi;
    const int G = gridDim.x, bx = blockIdx.x;
#ifndef PHMASK
#define PHMASK 127
#endif
#define IN(k) (((PHMASK >> (k)) & 1) && lo <= (k) && (k) < hi)
#define REP(k) for (int rep_ = 0; rep_ < (((DUPMASK >> (k)) & 1) ? 2 : 1); ++rep_)
    static_assert(XCD_BAR_WORDS == 3456, "barrier words");
    volatile LAS unsigned* bst = (volatile LAS unsigned*)(lds + 131072);
    if (threadIdx.x == 0) { bst[0] = 0u; bst[1] = 0u; }
    __syncthreads();
    const bool use_xb = (lo == 0 && hi == 7);
    XcdBarrier xbar; xbar.bar = (unsigned*)(ws + WS_BAR); xbar.x = 0; xbar.st = bst;
    if (use_xb) xbar = xcd_barrier_post((unsigned*)(ws + WS_BAR), bst);
#define SEAM(k) do { if (IN(k) && IN((k) + 1)) { if (!use_xb) grid.sync(); else xcd_barrier(xbar); } } while (0)
    if (IN(0)) REP(0) { prologue(A, out, ws, (LAS char*)lds); }
    SEAM(0);
    if (IN(1)) REP(1) {
        { pg8::Gemm g{(const bf16_t*)(ws + WS_XB), (const bf16_t*)(ws + WS_WIN), MT, NIN, 1024}; SchedIn S; S.so.init(MT, NIN, G, bx);
          EpiIn E{(const float*)(ws + WS_RSTD1), out, ws, A.in[13], A.in[14], A.in[15], A.in[16], A.in[17]};
          pg8::gemm_phase<EpiIn, SchedIn, true, true>(lds, g, S, E); }
        { const int wave = __builtin_amdgcn_readfirstlane(threadIdx.x >> 6); const int first = G > 60 ? G - 60 : 0;
          if (bx >= first) { for (int seq = (bx - first) * 8 + wave; seq < 288; seq += (G - first) * 8) cumsum_seq(A, out, ws, seq, threadIdx.x & 63);
                             late_weights(A, ws, (LAS char*)lds, (bx - first) * 8 + wave, (G - first) * 8); } }
    }
    SEAM(1);
    if (IN(2)) { attention_phase(A, out, ws, (LAS char*)lds, 0);
#if (DUPMASK >> 2) & 1
        attention_phase(A, out, ws, (LAS char*)lds, 1);
#endif
    }
    SEAM(2);
    if (IN(3)) {
        for (int t = bx; t < 256; t += G) sample_merge(ws, (LAS float*)lds, t);
        pg8::StaticOrder S; S.init(MP, 1024, G, bx);
        pg8::Gemm g{(const bf16_t*)(ws + WS_OC), (const bf16_t*)(ws + WS_WPC), MP, 1024, 1536}; EpiMergeH E{ws}; pg8::gemm_phase<EpiMergeH, pg8::StaticOrder, true, true>(lds, g, S, E);
#if (DUPMASK >> 3) & 1
        pg8::gemm_phase<EpiMergeH, pg8::StaticOrder, true, true>(lds, g, S, E);
#endif
    }
    SEAM(3);
    if (IN(4)) { for (int t = bx; t < 256; t += G) sample_wo(A.in[1], out, ws, (LAS float*)lds, t);
        pg8::Gemm g{(const bf16_t*)(ws + WS_H), (const bf16_t*)(ws + WS_WO), MP, 1024, 1024}; pg8::StaticOrder S; S.init(MP, 1024, G, bx);
#if (DUPMASK >> 4) & 1
        { EpiWo E0{A.in[0], A.in[1], (float*)(ws + WS_QA), (bf16_t*)(ws + WS_QA + ((size_t)80 << 20)), (float*)(ws + WS_QA + ((size_t)120 << 20))}; pg8::gemm_phase<EpiWo, pg8::StaticOrder, true, true>(lds, g, S, E0); }
#endif
        EpiWo E{A.in[0], A.in[1], out, (bf16_t*)(ws + WS_X1B), (float*)(ws + WS_SSQ2)}; pg8::gemm_phase<EpiWo, pg8::StaticOrder, true, true>(lds, g, S, E); }
    SEAM(4);
    if (IN(5)) { for (int t = bx; t < 512; t += G) sample_up(ws, (LAS float*)lds, t);
        pg8::Gemm g{(const bf16_t*)(ws + WS_X1B), (const bf16_t*)(ws + WS_WUP), MP, 4096, 1024}; pg8::StaticOrder S; S.init(MP, 4096, G, bx);
        EpiUp E{ws}; pg8::gemm_phase<EpiUp, pg8::StaticOrder, true, true>(lds, g, S, E);
#if (DUPMASK >> 5) & 1
        pg8::gemm_phase<EpiUp, pg8::StaticOrder, true, true>(lds, g, S, E);
#endif
    }
    SEAM(5);
    if (IN(6)) { for (int t = bx; t < 256; t += G) sample_down(out, ws, (LAS float*)lds, t);
        pg8::Gemm g{(const bf16_t*)(ws + WS_HF), (const bf16_t*)(ws + WS_WDN), MP, 1024, 4096}; pg8::StaticOrder S; S.init(MP, 1024, G, bx);
#if (DUPMASK >> 6) & 1
        { EpiDown E0{(float*)(ws + WS_OC), (const bf16_t*)(ws + WS_X1B)}; pg8::gemm_phase<EpiDown, pg8::StaticOrder, true, true>(lds, g, S, E0); }
#endif
        EpiDown E{out, (const bf16_t*)(ws + WS_X1B)}; pg8::gemm_phase<EpiDown, pg8::StaticOrder, true, true>(lds, g, S, E); }
#undef IN
#undef SEAM
}

#ifndef MK_SPLIT
#define MK_SPLIT 0
#endif
extern "C" void kernel_launch(void* const* d_in, const int* in_sizes, int n_in, void* d_out, int out_size, void* d_ws, size_t ws_size, hipStream_t stream) {
    static int grid = 0;
    if (grid == 0) {
        if (n_in != 29 || out_size != (int)O_END || ws_size < WS_END) { fprintf(stderr, "kernel_launch: unexpected shapes (n_in %d out %d ws %zu need %zu)\n", n_in, out_size, ws_size, (size_t)WS_END); grid = -1; return; }
        int dev = 0, cus = 0, per_cu = 0;
        hipGetDevice(&dev); hipDeviceGetAttribute(&cus, hipDeviceAttributeMultiprocessorCount, dev);
        if (hipFuncSetAttribute((const void*)mega_fwd, hipFuncAttributeMaxDynamicSharedMemorySize, LDS_BYTES) != hipSuccess) { fprintf(stderr, "kernel_launch: hipFuncSetAttribute failed\n"); grid = -1; return; }
        if (hipOccupancyMaxActiveBlocksPerMultiprocessor(&per_cu, (const void*)mega_fwd, 512, LDS_BYTES) != hipSuccess || per_cu < 1) { fprintf(stderr, "kernel_launch: occupancy query failed (%d)\n", per_cu); (void)hipGetLastError(); per_cu = 1; }
        grid = cus * 1;
        if (grid <= 0) grid = 256;
    }
    if (grid < 0) return;
    Args a{};
    for (int i = 0; i < 29; ++i) a.in[i] = (const float*)d_in[i];
    a.out = (float*)d_out; a.ws = (unsigned char*)d_ws;
#if MK_SPLIT
    for (int p = 0; p < 7; ++p) { a.ph_lo = p; a.ph_hi = p + 1; hipLaunchKernelGGL(mega_fwd, dim3(grid), dim3(512), LDS_BYTES, stream, a); }
#else
    a.ph_lo = 0; a.ph_hi = 7;
    if (hipMemsetAsync((char*)d_ws + WS_BAR, 0, 16384, stream) != hipSuccess) { fprintf(stderr, "kernel_launch: memset of the barrier words failed\n"); return; }
    void* kargs[] = {&a};
    hipError_t e = hipLaunchCooperativeKernel((const void*)mega_fwd, dim3(grid), dim3(512), kargs, LDS_BYTES, stream);
    if (e != hipSuccess) fprintf(stderr, "cooperative launch failed: %s (grid %d)\n", hipGetErrorString(e), grid);
#endif
}
```
